# Optimizing an MI355X kernel written in HIP

```python
import math
import jax, jax.numpy as jnp
from jax import lax
import numpy as np

D_MODEL = 1024
BATCH = 32
SEQ = 2048
DEPTH = 4
DEC_BATCH = 16
DEC_SEQ = 32
PAST_LEN = 1024

CHUNK = 64
N_MIXERS = 3
N_GDN = (DEPTH + 2) // 3
N_MLA = (DEPTH + 1) // 3
N_SWA = DEPTH // 3
EPS = 1e-6

GDN_HEADS = 8
GDN_DK = 128
GDN_DV = 128
GDN_CONV = 4
GDN_QKV = GDN_HEADS * (2 * GDN_DK + GDN_DV)
GDN_IN = GDN_QKV + GDN_HEADS * GDN_DV + 2 * GDN_HEADS

MLA_HEADS = 16
MLA_Q_LORA = 384
MLA_KV_LORA = 256
MLA_NOPE = 64
MLA_ROPE = 32
MLA_V = 64
MLA_IN = MLA_Q_LORA + MLA_KV_LORA + MLA_ROPE
ROPE_THETA = 10000.0
Q_BLOCK = 128

SWA_HEADS = 16
SWA_KV_HEADS = 4
SWA_GROUP = SWA_HEADS // SWA_KV_HEADS
SWA_HD = 64
WINDOW = 128
WIN_CHUNKS = WINDOW // CHUNK
SWA_IN = (SWA_HEADS + 2 * SWA_KV_HEADS) * SWA_HD

REL_BUCKETS = 32
REL_MAX_DIST = 128

D_FF = 2816
FFN_CONV = 3

kernel_name = 'hybrid_streaming_encoder_step'

F32 = jnp.float32


def rmsnorm(x, g):
    xf = x.astype(F32)
    y = xf * lax.rsqrt(jnp.mean(xf * xf, axis=-1, keepdims=True) + EPS)
    return (y * g.astype(F32)).astype(x.dtype)


def l2norm(x):
    xf = x.astype(F32)
    return xf * lax.rsqrt(jnp.sum(xf * xf, axis=-1, keepdims=True) + EPS)


def causal_dwconv(x, hist, w):
    K = w.shape[0]
    T = x.shape[1]
    xp = jnp.concatenate([hist.astype(x.dtype), x], axis=1)
    y = xp[:, 0:T] * w[0]
    for j in range(1, K):
        y = y + xp[:, j:j + T] * w[j]
    return y, xp[:, -(K - 1):]


def rope(x, pos):
    half = x.shape[-1] // 2
    inv = ROPE_THETA ** (-jnp.arange(half, dtype=F32) / half)
    ang = pos.astype(F32)[:, None] * inv[None, :]
    if x.ndim == 4:
        ang = ang[:, None, :]
    cos, sin = jnp.cos(ang), jnp.sin(ang)
    xf = x.astype(F32)
    x1, x2 = xf[..., :half], xf[..., half:]
    return jnp.concatenate([x1 * cos - x2 * sin, x1 * sin + x2 * cos], axis=-1).astype(x.dtype)


def t5_bias(table, q_pos, k_pos):
    n = q_pos[:, None] - k_pos[None, :]
    half = REL_BUCKETS // 2
    exact = half // 2
    side = jnp.where(n < 0, half, 0)
    n = jnp.abs(n)
    log_b = exact + (jnp.log(jnp.maximum(n, 1).astype(F32) / exact)
                     / math.log(REL_MAX_DIST / exact) * (half - exact)).astype(jnp.int32)
    bucket = side + jnp.where(n < exact, n, jnp.minimum(log_b, half - 1))
    bias = table[bucket].astype(F32).transpose(2, 0, 1)
    return bias.reshape(SWA_KV_HEADS, SWA_GROUP, q_pos.shape[0], k_pos.shape[0])


def gated_delta_rule(q, k, v, g, beta, S0, chunk):
    B, T, H, dk = q.shape
    dv = v.shape[-1]
    nc = T // chunk

    def blk4(a):
        return a.astype(F32).reshape(B, nc, chunk, H, a.shape[-1]).transpose(1, 0, 3, 2, 4)

    def blk3(a):
        return a.astype(F32).reshape(B, nc, chunk, H).transpose(1, 0, 3, 2)

    qc, kc, vc = blk4(q) * (dk ** -0.5), blk4(k), blk4(v)
    gc = jnp.cumsum(blk3(g), axis=-1)
    bc = blk3(beta)
    idx = jnp.arange(chunk)
    causal = idx[:, None] >= idx[None, :]
    decay = jnp.exp(jnp.where(causal, gc[..., :, None] - gc[..., None, :], -jnp.inf))
    kb = kc * bc[..., None]
    A = jnp.where(idx[:, None] > idx[None, :],
                  jnp.einsum('nbhid,nbhjd->nbhij', kb, kc) * decay, 0.0)
    eye = jnp.eye(chunk, dtype=F32)
    rhs = jnp.concatenate([vc * bc[..., None], kb * jnp.exp(gc)[..., None]], axis=-1)
    sol = lax.linalg.triangular_solve(eye + A, rhs, left_side=True, lower=True, unit_diagonal=True)
    w_v, w_k = sol[..., :dv], sol[..., dv:]
    qk = jnp.einsum('nbhid,nbhjd->nbhij', qc, kc) * decay

    def step(S, inp):
        qi, ki, wv, wk, qki, gi = inp
        u = wv - jnp.einsum('bhik,bhkv->bhiv', wk, S)
        o = (jnp.einsum('bhik,bhkv->bhiv', qi * jnp.exp(gi)[..., None], S)
             + jnp.einsum('bhij,bhjv->bhiv', qki, u))
        gl = gi[..., -1:]
        S = (S * jnp.exp(gl)[..., None]
             + jnp.einsum('bhik,bhiv->bhkv', ki * jnp.exp(gl - gi)[..., None], u))
        return S, o

    S, o = lax.scan(step, S0, (qc, kc, w_v, w_k, qk, gc))
    o = o.transpose(1, 0, 3, 2, 4).reshape(B, T, H, dv)
    return o, S


def gdn_mixer(h, hist, S0, w_in, conv_w, a_log, dt_bias, o_norm, w_o, chunk):
    B, T, _ = h.shape
    H, dk, dv = GDN_HEADS, GDN_DK, GDN_DV
    proj = h @ w_in
    qkv = proj[..., :GDN_QKV]
    z = proj[..., GDN_QKV:GDN_QKV + H * dv].reshape(B, T, H, dv)
    a = proj[..., GDN_QKV + H * dv:GDN_QKV + H * dv + H]
    b = proj[..., GDN_QKV + H * dv + H:]
    conv, new_hist = causal_dwconv(qkv, hist, conv_w)
    conv = jax.nn.silu(conv)
    q = l2norm(conv[..., :H * dk].reshape(B, T, H, dk))
    k = l2norm(conv[..., H * dk:2 * H * dk].reshape(B, T, H, dk))
    v = conv[..., 2 * H * dk:].reshape(B, T, H, dv)
    g = -jnp.exp(a_log.astype(F32)) * jax.nn.softplus(a.astype(F32) + dt_bias.astype(F32))
    beta = jax.nn.sigmoid(b.astype(F32))
    o, S = gated_delta_rule(q, k, v, g, beta, S0.astype(F32), chunk)
    o = rmsnorm(o, o_norm) * jax.nn.silu(z.astype(F32))
    out = o.reshape(B, T, H * dv).astype(h.dtype) @ w_o
    return out, new_hist, S.astype(h.dtype)


def mla_project(h, pos, w_in, q_norm, kv_norm, w_q_up):
    B, T, _ = h.shape
    proj = h @ w_in
    cq = rmsnorm(proj[..., :MLA_Q_LORA], q_norm)
    ckv = rmsnorm(proj[..., MLA_Q_LORA:MLA_Q_LORA + MLA_KV_LORA], kv_norm)
    kr = rope(proj[..., MLA_Q_LORA + MLA_KV_LORA:], pos)
    q = (cq @ w_q_up).reshape(B, T, MLA_HEADS, MLA_NOPE + MLA_ROPE)
    return q[..., :MLA_NOPE], rope(q[..., MLA_NOPE:], pos), ckv, kr


def mla_attend(qn, qr, q_pos, ckv, kr, k_pos, w_kv_up, w_o):
    B, Tq = qn.shape[:2]
    Tk = ckv.shape[1]
    kv = (ckv @ w_kv_up).reshape(B, Tk, MLA_HEADS, MLA_NOPE + MLA_V)
    k_nope, v = kv[..., :MLA_NOPE], kv[..., MLA_NOPE:]
    scale = (MLA_NOPE + MLA_ROPE) ** -0.5
    k_chunk = k_pos // CHUNK

    def block(args):
        qnb, qrb, qpb = args
        s = (jnp.einsum('bqhd,bkhd->bhqk', qnb, k_nope)
             + jnp.einsum('bqhr,bkr->bhqk', qrb, kr)).astype(F32) * scale
        mask = k_chunk[None, :] <= (qpb // CHUNK)[:, None]
        p = jax.nn.softmax(jnp.where(mask, s, -jnp.inf), axis=-1)
        return jnp.einsum('bhqk,bkhd->bqhd', p.astype(v.dtype), v)

    qb = min(Q_BLOCK, Tq)
    nb = Tq // qb
    qn_b = qn.reshape(B, nb, qb, MLA_HEADS, MLA_NOPE).transpose(1, 0, 2, 3, 4)
    qr_b = qr.reshape(B, nb, qb, MLA_HEADS, MLA_ROPE).transpose(1, 0, 2, 3, 4)
    o = lax.map(block, (qn_b, qr_b, q_pos.reshape(nb, qb)))
    o = o.transpose(1, 0, 2, 3, 4).reshape(B, Tq, MLA_HEADS * MLA_V)
    return o @ w_o


def swa_project(h, w_in):
    B, T, _ = h.shape
    proj = h @ w_in
    nq, nk = SWA_HEADS * SWA_HD, SWA_KV_HEADS * SWA_HD
    q = proj[..., :nq].reshape(B, T, SWA_KV_HEADS, SWA_GROUP, SWA_HD)
    k = proj[..., nq:nq + nk].reshape(B, T, SWA_KV_HEADS, SWA_HD)
    v = proj[..., nq + nk:].reshape(B, T, SWA_KV_HEADS, SWA_HD)
    return q, k, v


def sink_attend(q, k, v, bias, mask, sinks):
    s = jnp.einsum('bnqhgd,bnshd->bnhgqs', q, k).astype(F32) * (SWA_HD ** -0.5) + bias
    s = jnp.where(mask[:, None, None], s, -jnp.inf)
    sink = sinks.astype(F32).reshape(SWA_KV_HEADS, SWA_GROUP, 1, 1)
    m = jnp.maximum(jnp.max(s, axis=-1, keepdims=True), sink)
    p = jnp.exp(s - m)
    p = p / (jnp.sum(p, axis=-1, keepdims=True) + jnp.exp(sink - m))
    return jnp.einsum('bnhgqs,bnshd->bnqhgd', p.astype(v.dtype), v)


def band(a):
    B, T = a.shape[:2]
    nc = T // CHUNK
    ac = a.reshape(B, nc, CHUNK, SWA_KV_HEADS, SWA_HD)
    ap = jnp.pad(ac, ((0, 0), (WIN_CHUNKS, 0), (0, 0), (0, 0), (0, 0)))
    return jnp.concatenate([ap[:, j:j + nc] for j in range(WIN_CHUNKS + 1)], axis=2)


def swa_prompt(q, k, v, rel_bias, sinks):
    B, T = q.shape[:2]
    nc = T // CHUNK
    span = (WIN_CHUNKS + 1) * CHUNK
    qb = q.reshape(B, nc, CHUNK, SWA_KV_HEADS, SWA_GROUP, SWA_HD)
    q_rel = WIN_CHUNKS * CHUNK + jnp.arange(CHUNK)
    k_rel = jnp.arange(span)
    bias = t5_bias(rel_bias, q_rel, k_rel)
    k_chunk = jnp.arange(nc)[:, None] - WIN_CHUNKS + (k_rel // CHUNK)[None, :]
    mask = jnp.broadcast_to((k_chunk >= 0)[:, None, :], (nc, CHUNK, span))
    o = sink_attend(qb, band(k), band(v), bias, mask, sinks)
    return o.reshape(B, T, SWA_HEADS * SWA_HD)


def swa_sample(q, q_pos, k_all, v_all, k_pos, rel_bias, sinks):
    B, T = q.shape[:2]
    d = (q_pos // CHUNK)[:, None] - (k_pos // CHUNK)[None, :]
    mask = ((d >= 0) & (d <= WIN_CHUNKS))[None]
    bias = t5_bias(rel_bias, q_pos, k_pos)
    o = sink_attend(q[:, None], k_all[:, None], v_all[:, None], bias, mask, sinks)
    return o.reshape(B, T, SWA_HEADS * SWA_HD)


def conv_ffn(h, hist, w_in, conv_w, conv_b, w_out):
    proj = h @ w_in
    gate, up = proj[..., :D_FF], proj[..., D_FF:]
    gate_c, new_hist = causal_dwconv(gate, hist, conv_w)
    return (jax.nn.silu(gate_c + conv_b) * up) @ w_out, new_hist


def trunk(x, c, prompt, past_len, st, p):
    B, T, _ = x.shape
    pos = jnp.arange(T, dtype=jnp.int32) + (0 if prompt else past_len)
    new = dict(gdn_conv=[], gdn_S=[], mla_latent=[], mla_krope=[], swa_k=[], swa_v=[], ffn_conv=[])
    cs = jax.nn.silu(c)
    for layer in range(DEPTH):
        kind, slot = layer % N_MIXERS, layer // N_MIXERS
        mod = cs @ p['ada_w'][layer] + p['ada_b'][layer]
        sh1, sc1, g1, sh2, sc2, g2 = jnp.split(mod[:, None, :], 6, axis=-1)
        h = rmsnorm(x, p['norm1'][layer]) * (1 + sc1) + sh1
        if kind == 0:
            mix, conv_h, S = gdn_mixer(h, st['gdn_conv'][slot], st['gdn_S'][slot], p['gdn_w_in'][slot],
                                       p['gdn_conv_w'][slot], p['gdn_a_log'][slot], p['gdn_dt_bias'][slot],
                                       p['gdn_o_norm'][slot], p['gdn_w_o'][slot], CHUNK if prompt else T)
            new['gdn_conv'].append(conv_h)
            new['gdn_S'].append(S)
        elif kind == 1:
            qn, qr, ckv, kr = mla_project(h, pos, p['mla_w_in'][slot], p['mla_q_norm'][slot],
                                          p['mla_kv_norm'][slot], p['mla_w_q_up'][slot])
            if prompt:
                ckv_all, kr_all, k_pos = ckv, kr, pos
            else:
                ckv_all = jnp.concatenate([st['mla_latent'][slot].astype(ckv.dtype), ckv], axis=1)
                kr_all = jnp.concatenate([st['mla_krope'][slot].astype(kr.dtype), kr], axis=1)
                k_pos = jnp.arange(past_len + T, dtype=jnp.int32)
            mix = mla_attend(qn, qr, pos, ckv_all, kr_all, k_pos, p['mla_w_kv_up'][slot], p['mla_w_o'][slot])
            new['mla_latent'].append(ckv)
            new['mla_krope'].append(kr)
        else:
            q, k, v = swa_project(h, p['swa_w_in'][slot])
            if prompt:
                heads = swa_prompt(q, k, v, p['rel_bias'], p['swa_sinks'][slot])
                win = min(WINDOW, T)
                new_k, new_v = k[:, -win:], v[:, -win:]
            else:
                win = st['swa_k'].shape[2]
                k_all = jnp.concatenate([st['swa_k'][slot].astype(k.dtype), k], axis=1)
                v_all = jnp.concatenate([st['swa_v'][slot].astype(v.dtype), v], axis=1)
                k_pos = jnp.concatenate([past_len - win + jnp.arange(win, dtype=jnp.int32), pos])
                heads = swa_sample(q, pos, k_all, v_all, k_pos, p['rel_bias'], p['swa_sinks'][slot])
                new_k, new_v = k_all[:, -win:], v_all[:, -win:]
            mix = heads @ p['swa_w_o'][slot]
            new['swa_k'].append(new_k)
            new['swa_v'].append(new_v)
        x = x + g1 * mix
        h = rmsnorm(x, p['norm2'][layer]) * (1 + sc2) + sh2
        f, f_hist = conv_ffn(h, st['ffn_conv'][layer], p['ffn_w_in'][layer], p['ffn_conv_w'][layer],
                             p['ffn_conv_b'][layer], p['ffn_w_out'][layer])
        new['ffn_conv'].append(f_hist)
        x = x + g2 * f
    y = rmsnorm(x, p['final_norm'])
    return y, {name: jnp.stack(rows) for name, rows in new.items()}


def setup_inputs(seed: int = 0) -> dict:
    key = jax.random.key(seed)
    ks = iter(jax.random.split(key, 48))

    def nrm(shape, scale=1.0):
        return jax.random.normal(next(ks), shape, F32) * scale

    def gain(shape):
        return 1.0 + nrm(shape, 0.02)

    win = min(WINDOW, PAST_LEN)
    a_log = jnp.log(jax.random.uniform(next(ks), (N_GDN, GDN_HEADS), F32, minval=1.0, maxval=16.0))
    dt = jnp.exp(jax.random.uniform(next(ks), (N_GDN, GDN_HEADS), F32,
                                    minval=math.log(1e-3), maxval=math.log(1e-1)))
    dt_bias = dt + jnp.log(-jnp.expm1(-dt))
    return {
        'x_prompt': nrm((BATCH, SEQ, D_MODEL)),
        'x_sample': nrm((DEC_BATCH, DEC_SEQ, D_MODEL)),
        'c_prompt': nrm((BATCH, D_MODEL)),
        'c_sample': nrm((DEC_BATCH, D_MODEL)),
        'state_gdn_conv': nrm((N_GDN, DEC_BATCH, GDN_CONV - 1, GDN_QKV)),
        'state_gdn_S': nrm((N_GDN, DEC_BATCH, GDN_HEADS, GDN_DK, GDN_DV), 0.1),
        'cache_mla_latent': nrm((N_MLA, DEC_BATCH, PAST_LEN, MLA_KV_LORA)),
        'cache_mla_krope': nrm((N_MLA, DEC_BATCH, PAST_LEN, MLA_ROPE)),
        'cache_swa_k': nrm((N_SWA, DEC_BATCH, win, SWA_KV_HEADS, SWA_HD)),
        'cache_swa_v': nrm((N_SWA, DEC_BATCH, win, SWA_KV_HEADS, SWA_HD)),
        'state_ffn_conv': nrm((DEPTH, DEC_BATCH, FFN_CONV - 1, D_FF)),
        'ada_w': nrm((DEPTH, D_MODEL, 6 * D_MODEL), 0.02),
        'ada_b': nrm((DEPTH, 6 * D_MODEL), 0.02),
        'norm1': gain((DEPTH, D_MODEL)),
        'norm2': gain((DEPTH, D_MODEL)),
        'final_norm': gain((D_MODEL,)),
        'gdn_w_in': nrm((N_GDN, D_MODEL, GDN_IN), D_MODEL ** -0.5),
        'gdn_conv_w': nrm((N_GDN, GDN_CONV, GDN_QKV), GDN_CONV ** -0.5),
        'gdn_a_log': a_log,
        'gdn_dt_bias': dt_bias,
        'gdn_o_norm': gain((N_GDN, GDN_DV)),
        'gdn_w_o': nrm((N_GDN, GDN_HEADS * GDN_DV, D_MODEL), (GDN_HEADS * GDN_DV) ** -0.5),
        'mla_w_in': nrm((N_MLA, D_MODEL, MLA_IN), D_MODEL ** -0.5),
        'mla_q_norm': gain((N_MLA, MLA_Q_LORA)),
        'mla_kv_norm': gain((N_MLA, MLA_KV_LORA)),
        'mla_w_q_up': nrm((N_MLA, MLA_Q_LORA, MLA_HEADS * (MLA_NOPE + MLA_ROPE)), MLA_Q_LORA ** -0.5),
        'mla_w_kv_up': nrm((N_MLA, MLA_KV_LORA, MLA_HEADS * (MLA_NOPE + MLA_V)), MLA_KV_LORA ** -0.5),
        'mla_w_o': nrm((N_MLA, MLA_HEADS * MLA_V, D_MODEL), (MLA_HEADS * MLA_V) ** -0.5),
        'swa_w_in': nrm((N_SWA, D_MODEL, SWA_IN), D_MODEL ** -0.5),
        'swa_sinks': nrm((N_SWA, SWA_HEADS)),
        'swa_w_o': nrm((N_SWA, SWA_HEADS * SWA_HD, D_MODEL), (SWA_HEADS * SWA_HD) ** -0.5),
        'rel_bias': nrm((REL_BUCKETS, SWA_HEADS), 0.5),
        'ffn_w_in': nrm((DEPTH, D_MODEL, 2 * D_FF), D_MODEL ** -0.5),
        'ffn_conv_w': nrm((DEPTH, FFN_CONV, D_FF), FFN_CONV ** -0.5),
        'ffn_conv_b': nrm((DEPTH, D_FF), 0.02),
        'ffn_w_out': nrm((DEPTH, D_FF, D_MODEL), D_FF ** -0.5),
    }


def reference(x_prompt, x_sample, c_prompt, c_sample, state_gdn_conv, state_gdn_S, cache_mla_latent,
              cache_mla_krope, cache_swa_k, cache_swa_v, state_ffn_conv, ada_w, ada_b, norm1, norm2,
              final_norm, gdn_w_in, gdn_conv_w, gdn_a_log, gdn_dt_bias, gdn_o_norm, gdn_w_o, mla_w_in,
              mla_q_norm, mla_kv_norm, mla_w_q_up, mla_w_kv_up, mla_w_o, swa_w_in, swa_sinks, swa_w_o,
              rel_bias, ffn_w_in, ffn_conv_w, ffn_conv_b, ffn_w_out):
    p = dict(ada_w=ada_w, ada_b=ada_b, norm1=norm1, norm2=norm2, final_norm=final_norm,
             gdn_w_in=gdn_w_in, gdn_conv_w=gdn_conv_w, gdn_a_log=gdn_a_log, gdn_dt_bias=gdn_dt_bias,
             gdn_o_norm=gdn_o_norm, gdn_w_o=gdn_w_o, mla_w_in=mla_w_in, mla_q_norm=mla_q_norm,
             mla_kv_norm=mla_kv_norm, mla_w_q_up=mla_w_q_up, mla_w_kv_up=mla_w_kv_up, mla_w_o=mla_w_o,
             swa_w_in=swa_w_in, swa_sinks=swa_sinks, swa_w_o=swa_w_o, rel_bias=rel_bias,
             ffn_w_in=ffn_w_in, ffn_conv_w=ffn_conv_w, ffn_conv_b=ffn_conv_b, ffn_w_out=ffn_w_out)
    bp = x_prompt.shape[0]
    st_prompt = dict(gdn_conv=jnp.zeros((N_GDN, bp, GDN_CONV - 1, GDN_QKV), x_prompt.dtype),
                     gdn_S=jnp.zeros((N_GDN, bp, GDN_HEADS, GDN_DK, GDN_DV), F32),
                     ffn_conv=jnp.zeros((DEPTH, bp, FFN_CONV - 1, D_FF), x_prompt.dtype))
    st_sample = dict(gdn_conv=state_gdn_conv, gdn_S=state_gdn_S, mla_latent=cache_mla_latent,
                     mla_krope=cache_mla_krope, swa_k=cache_swa_k, swa_v=cache_swa_v,
                     ffn_conv=state_ffn_conv)
    past_len = cache_mla_latent.shape[2]
    y_prompt, sp = trunk(x_prompt, c_prompt, True, 0, st_prompt, p)
    y_sample, ss = trunk(x_sample, c_sample, False, past_len, st_sample, p)
    return (y_prompt, y_sample,
            sp['gdn_conv'], ss['gdn_conv'],
            sp['gdn_S'], ss['gdn_S'],
            sp['mla_latent'], ss['mla_latent'],
            sp['mla_krope'], ss['mla_krope'],
            sp['swa_k'], ss['swa_k'],
            sp['swa_v'], ss['swa_v'],
            sp['ffn_conv'], ss['ffn_conv'])
```

```cpp
#include <hip/hip_runtime.h>
#include <hip/hip_cooperative_groups.h>
#include <cstdio>
#include <cstdint>
namespace cg = cooperative_groups;

#define LAS __attribute__((address_space(3)))
#define OPAQUE_V(x) asm volatile("" : "+v"(x))
#define OPAQUE_S(x) asm volatile("" : "+s"(x))
__device__ __forceinline__ int tidx() { int t = threadIdx.x; OPAQUE_V(t); return t; }
__device__ __forceinline__ int bidx() { int b = blockIdx.x; OPAQUE_S(b); return b; }
typedef unsigned short bf16_t;
typedef short bf16x8 __attribute__((ext_vector_type(8)));
typedef short bf16x4 __attribute__((ext_vector_type(4)));
typedef float f32x4 __attribute__((ext_vector_type(4)));
typedef float f32x2 __attribute__((ext_vector_type(2)));
typedef unsigned u32x4 __attribute__((ext_vector_type(4)));
typedef unsigned u32x2 __attribute__((ext_vector_type(2)));

constexpr int D = 1024, NTP = 65536, NTS = 512, MT = NTP + NTS, NSEQ = 48;
constexpr int MK = NTP + 16 * 1056;
constexpr int DFF = 2816;
constexpr int XS = 2048;
constexpr float EPS = 1e-6f;
constexpr int NTHREADS = 512;
constexpr int LDS_BYTES = 163840;
constexpr int XST_OFF = LDS_BYTES - 16, CWL_OFF = 131072;

constexpr size_t O_Y = 0;
constexpr size_t O_YS = O_Y + (size_t)NTP * D;
constexpr size_t O_GCP = O_YS + (size_t)NTS * D;
constexpr size_t O_GCS = O_GCP + 2ull * 32 * 3 * 3072;
constexpr size_t O_GSP = O_GCS + 2ull * 16 * 3 * 3072;
constexpr size_t O_GSS = O_GSP + 2ull * 32 * 8 * 16384;
constexpr size_t O_MLP = O_GSS + 2ull * 16 * 8 * 16384;
constexpr size_t O_MLS = O_MLP + 32ull * 2048 * 256;
constexpr size_t O_MKP = O_MLS + 16ull * 32 * 256;
constexpr size_t O_MKS = O_MKP + 32ull * 2048 * 32;
constexpr size_t O_SKP = O_MKS + 16ull * 32 * 32;
constexpr size_t O_SKS = O_SKP + 32ull * 128 * 256;
constexpr size_t O_SVP = O_SKS + 16ull * 128 * 256;
constexpr size_t O_SVS = O_SVP + 32ull * 128 * 256;
constexpr size_t O_FCP = O_SVS + 16ull * 128 * 256;
constexpr size_t O_FCS = O_FCP + 4ull * 32 * 2 * DFF;
constexpr size_t O_END = O_FCS + 4ull * 16 * 2 * DFF;

constexpr size_t al256(size_t x) { return (x + 255) & ~(size_t)255; }
constexpr size_t WS_BAR = 0;
constexpr size_t WS_MOD = 16384;
constexpr size_t WS_ROPE = al256(WS_MOD + 4ull * 48 * 6144 * 4);
constexpr size_t WS_BIAS = al256(WS_ROPE + 2048ull * 16 * 8);
constexpr size_t WS_SWAKC = al256(WS_BIAS + 16ull * 256 * 4);
constexpr size_t WS_SWAVC = al256(WS_SWAKC + 16ull * 128 * 256 * 2);
constexpr size_t WS_WT = al256(WS_SWAVC + 16ull * 128 * 256 * 2);
constexpr size_t WT_GIN = 0;
constexpr size_t WT_GO = WT_GIN + 2ull * 4352 * 1024;
constexpr size_t WT_MIN = WT_GO + 2ull * 1024 * 1024;
constexpr size_t WT_QUP = WT_MIN + 768ull * 1024;
constexpr size_t WT_KVUP = WT_QUP + 1536ull * 384;
constexpr size_t WT_MO = WT_KVUP + 2048ull * 256;
constexpr size_t WT_SIN = WT_MO + 1024ull * 1024;
constexpr size_t WT_SO = WT_SIN + 1536ull * 1024;
constexpr size_t WT_FIN = WT_SO + 1024ull * 1024;
constexpr size_t WT_FOUT = WT_FIN + 4ull * 5632 * 1024;
constexpr size_t WT_END = WT_FOUT + 4ull * 1024 * 2816;
constexpr size_t WS_H = al256(WS_WT + WT_END * 2);
constexpr size_t WS_BIG = al256(WS_H + (size_t)MT * 1024 * 2);
constexpr size_t BG_QKV = WS_BIG;
constexpr size_t BG_Z = al256(BG_QKV + (size_t)MT * 3072 * 2);
constexpr size_t BG_AB = al256(BG_Z + (size_t)MT * 1024 * 2);
constexpr size_t BG_KN = al256(BG_AB + (size_t)MT * 16 * 4);
constexpr size_t BG_TB = al256(BG_KN + (size_t)MT * 1024 * 2);
constexpr size_t BG_GB = al256(BG_TB + 8320ull * 4096 * 2);
constexpr size_t BG_END = al256(BG_GB + 8320ull * 128 * 4);
constexpr size_t BM_PROJ = WS_BIG;
constexpr size_t BM_CQ = al256(BM_PROJ + (size_t)MT * 768 * 2);
constexpr size_t BM_CKV = al256(BM_CQ + (size_t)MT * 384 * 2);
constexpr size_t BM_KR = al256(BM_CKV + (size_t)(MK + 64) * 256 * 2);
constexpr size_t BM_Q = al256(BM_KR + (size_t)(MK + 64) * 32 * 2);
constexpr size_t BM_KV = al256(BM_Q + (size_t)MT * 1536 * 2);
constexpr size_t BM_END = al256(BM_KV + (size_t)(MK + 64) * 2048 * 2);
constexpr size_t BS_PROJ = WS_BIG;
constexpr size_t BF_U = WS_BIG;
constexpr size_t BF_GD = al256(BF_U + (size_t)MT * DFF * 2);
constexpr size_t BF_UD = al256(BF_GD + (size_t)(MT / 32) * 4 * DFF * 4);
constexpr size_t BF_END = al256(BF_UD + (size_t)(MT / 32) * 2 * DFF * 4);
constexpr size_t WS_NEED = (BM_END > BF_END ? (BM_END > BG_END ? BM_END : BG_END) : (BF_END > BG_END ? BF_END : BG_END));

struct Args {
    const float* in[36];
    float* out;
    unsigned char* ws;
};

__device__ __forceinline__ float bf2f(bf16_t b) { return __uint_as_float(((unsigned)b) << 16); }
__device__ __forceinline__ bf16_t f2bf(float f) { unsigned u = __float_as_uint(f); u += 0x7FFFu + ((u >> 16) & 1u); return (bf16_t)(u >> 16); }
typedef __bf16 bf16v2_t __attribute__((ext_vector_type(2)));
__device__ __forceinline__ unsigned pk2(float lo, float hi) { const f32x2 v = {lo, hi}; const bf16v2_t b = __builtin_convertvector(v, bf16v2_t); return __builtin_bit_cast(unsigned, b); }
__device__ __forceinline__ float siluf(float x) { return x * __builtin_amdgcn_rcpf(1.f + __expf(-x)); }
__device__ __forceinline__ float sigmoidf_(float x) { return __builtin_amdgcn_rcpf(1.f + __expf(-x)); }
__device__ __forceinline__ int seq_of(int row) { return row < NTP ? (row >> 11) : 32 + ((row - NTP) >> 5); }
__device__ __forceinline__ void unpack8(const u32x4 v, float* f) {
    f[0] = __uint_as_float(v.x << 16); f[1] = __uint_as_float(v.x & 0xFFFF0000u);
    f[2] = __uint_as_float(v.y << 16); f[3] = __uint_as_float(v.y & 0xFFFF0000u);
    f[4] = __uint_as_float(v.z << 16); f[5] = __uint_as_float(v.z & 0xFFFF0000u);
    f[6] = __uint_as_float(v.w << 16); f[7] = __uint_as_float(v.w & 0xFFFF0000u);
}
__device__ __forceinline__ f32x4 bf4(const u32x2 t) { return (f32x4){__uint_as_float(t.x << 16), __uint_as_float(t.x & 0xFFFF0000u), __uint_as_float(t.y << 16), __uint_as_float(t.y & 0xFFFF0000u)}; }
__device__ __forceinline__ u32x4 pack8(const float* f) { u32x4 o; o.x = pk2(f[0], f[1]); o.y = pk2(f[2], f[3]); o.z = pk2(f[4], f[5]); o.w = pk2(f[6], f[7]); return o; }

__device__ __forceinline__ f32x4 mm16(const LAS bf16_t* A, int lda, const LAS bf16_t* Bt, int ldb, int K, f32x4 acc, int lane) {
    const int r = lane & 15, q = lane >> 4;
    const LAS bf16_t* ap = A + r * lda + q * 8; const LAS bf16_t* bp = Bt + r * ldb + q * 8;
    for (int k = 0; k < K; k += 32) {
        const bf16x8 av = *(const LAS bf16x8*)(ap + k);
        const bf16x8 bv = *(const LAS bf16x8*)(bp + k);
        acc = __builtin_amdgcn_mfma_f32_16x16x32_bf16(av, bv, acc, 0, 0, 0);
    }
    return acc;
}

template <int NK> __device__ __forceinline__ void ldfrag(const LAS bf16_t* M, int ld, bf16x8 (&f)[NK], int lane) {
    const LAS bf16_t* p = M + (lane & 15) * ld + (lane >> 4) * 8;
#pragma unroll
    for (int k = 0; k < NK; ++k) f[k] = *(const LAS bf16x8*)(p + 32 * k);
}
template <int NK> __device__ __forceinline__ f32x4 mm16b(const LAS bf16_t* A, int lda, const bf16x8 (&bf)[NK], f32x4 acc, int lane) {
    const LAS bf16_t* ap = A + (lane & 15) * lda + (lane >> 4) * 8;
#pragma unroll
    for (int k = 0; k < NK; ++k) acc = __builtin_amdgcn_mfma_f32_16x16x32_bf16(*(const LAS bf16x8*)(ap + 32 * k), bf[k], acc, 0, 0, 0);
    return acc;
}
template <int NK> __device__ __forceinline__ f32x4 mm16a(const bf16x8 (&af)[NK], const LAS bf16_t* Bt, int ldb, f32x4 acc, int lane) {
    const LAS bf16_t* bp = Bt + (lane & 15) * ldb + (lane >> 4) * 8;
#pragma unroll
    for (int k = 0; k < NK; ++k) acc = __builtin_amdgcn_mfma_f32_16x16x32_bf16(af[k], *(const LAS bf16x8*)(bp + 32 * k), acc, 0, 0, 0);
    return acc;
}

namespace pg8 {
constexpr int BM = 256, BK = 64, HALF = 128, HTB = HALF * BK * 2, STAGE_BYTES = 8 * HTB, NXCD = 8, WGM = 8;
__device__ __forceinline__ int lds_byte(int r, int c) { const int st = (r >> 4) * 2 + (c >> 5), rr = r & 15, cc = c & 31, ob = rr * 64 + cc * 2; return st * 1024 + (ob ^ (((ob >> 9) & 1) << 5)); }
__device__ __forceinline__ void stage_rc(int b, int& R, int& C) { const int st = b / 1024, sb = b % 1024, swz = sb ^ (((sb >> 9) & 1) << 5); R = (st >> 1) * 16 + swz / 64; C = (st & 1) * 32 + (swz % 64) / 2; }
__device__ __forceinline__ int perm32(int rho) { const int n = rho >> 4, i = rho & 15; return 8 * (i >> 2) + 4 * n + (i & 3); }
struct Unit { int pm, pn; };
struct StaticOrder {
    int nM, nN, nwg, G, c;
    __device__ void init(int M, int N, int G_, int c_) { nM = M / BM; nN = N / BM; nwg = nM * nN; G = G_; c = c_; }
    __device__ bool next(int i, Unit& u) const {
        const long L = (long)i * G + c; if (L >= nwg) return false;
        int wgid = (int)L; { const int q = nwg / NXCD, r = nwg % NXCD, xcd = wgid % NXCD, off = wgid / NXCD; wgid = (xcd < r ? xcd * (q + 1) : r * (q + 1) + (xcd - r) * q) + off; }
        const int nig = WGM * nN, gid = wgid / nig, fm = gid * WGM, gsz = (nM - fm) < WGM ? (nM - fm) : WGM;
        u.pm = fm + ((wgid % nig) % gsz); u.pn = (wgid % nig) / gsz; return true;
    }
};
}

struct Epi {
    int mode;
    float* X; const float* srcP; const float* srcS; const float* gate;
    bf16_t* o0; int ld0; int t1; bf16_t* o1; int ld1; int t2; float* o2;
    float* ud; const float* cw; const float* cb; const LAS bf16_t* cwl;
    __device__ __forceinline__ void operator()(const f32x4 (&acc)[2][2][4][2], const pg8::Unit& u, int wr, int wc, int fr, int fq) const {
        const int row0 = u.pm * 256 + wr * 64 + fr;
        if (mode == 0) {
            const int c0 = u.pn * 256 + wc * 32 + 8 * fq;
            bf16_t* X16 = (bf16_t*)X;
            const bool uni = u.pm < 256;
            f32x4 gU[2][2];
            if (uni) { const float* gp = gate + (size_t)seq_of(u.pm * 256) * 6144 + c0;
#pragma unroll
                for (int bj = 0; bj < 2; ++bj)
#pragma unroll
                    for (int n = 0; n < 2; ++n) gU[bj][n] = *(const f32x4*)(gp + bj * 128 + 4 * n); }
            if (srcP) {
#pragma unroll
                for (int am = 0; am < 4; ++am) {
                    const int ai = am >> 1, m0 = (am & 1) * 2;
                    f32x4 xv[2][2][2];
#pragma unroll
                    for (int mm = 0; mm < 2; ++mm) {
                        const int row = row0 + ai * 128 + (m0 + mm) * 16;
                        const float* sp = (row < NTP ? srcP + (size_t)row * D : srcS + (size_t)(row - NTP) * D) + c0;
#pragma unroll
                        for (int bj = 0; bj < 2; ++bj)
#pragma unroll
                            for (int n = 0; n < 2; ++n) xv[mm][bj][n] = *(const f32x4*)(sp + bj * 128 + 4 * n);
                    }
#pragma unroll
                    for (int mm = 0; mm < 2; ++mm) {
                        const int row = row0 + ai * 128 + (m0 + mm) * 16;
                        const float* gp = gate + (size_t)seq_of(row) * 6144 + c0;
#pragma unroll
                        for (int bj = 0; bj < 2; ++bj) {
                            const f32x4 g0 = uni ? gU[bj][0] : *(const f32x4*)(gp + bj * 128), g1 = uni ? gU[bj][1] : *(const f32x4*)(gp + bj * 128 + 4);
                            const f32x4 y0 = xv[mm][bj][0] + g0 * acc[ai][bj][m0 + mm][0], y1 = xv[mm][bj][1] + g1 * acc[ai][bj][m0 + mm][1];
                            u32x4 w; w.x = pk2(y0[0], y0[1]); w.y = pk2(y0[2], y0[3]); w.z = pk2(y1[0], y1[1]); w.w = pk2(y1[2], y1[3]);
                            *(u32x4*)(X16 + (size_t)row * XS + c0 + bj * 128) = w;
                        }
                    }
                    __builtin_amdgcn_sched_barrier(0);
                }
            } else {
#pragma unroll
                for (int ai = 0; ai < 2; ++ai) {
                    u32x4 xv[4][2];
#pragma unroll
                    for (int m = 0; m < 4; ++m)
#pragma unroll
                        for (int bj = 0; bj < 2; ++bj) xv[m][bj] = *(const u32x4*)(X16 + (size_t)(row0 + ai * 128 + m * 16) * XS + c0 + bj * 128);
#pragma unroll
                    for (int m = 0; m < 4; ++m) {
                        const int row = row0 + ai * 128 + m * 16;
                        const float* gp = gate + (size_t)seq_of(row) * 6144 + c0;
#pragma unroll
                        for (int bj = 0; bj < 2; ++bj) {
                            const f32x4 g0 = uni ? gU[bj][0] : *(const f32x4*)(gp + bj * 128), g1 = uni ? gU[bj][1] : *(const f32x4*)(gp + bj * 128 + 4);
                            float x[8]; unpack8(xv[m][bj], x);
                            const f32x4 a0 = acc[ai][bj][m][0], a1 = acc[ai][bj][m][1];
                            u32x4 w; w.x = pk2(x[0] + g0[0] * a0[0], x[1] + g0[1] * a0[1]); w.y = pk2(x[2] + g0[2] * a0[2], x[3] + g0[3] * a0[3]);
                            w.z = pk2(x[4] + g1[0] * a1[0], x[5] + g1[1] * a1[1]); w.w = pk2(x[6] + g1[2] * a1[2], x[7] + g1[3] * a1[3]);
                            *(u32x4*)(X16 + (size_t)row * XS + c0 + bj * 128) = w;
                        }
                    }
                    __builtin_amdgcn_sched_barrier(0);
                }
            }
        } else if (mode == 2) {
            const int c0 = u.pn * 128 + wc * 32 + 8 * fq;
            f32x4 w0[2], w1[2], w2[2], bb[2];
#pragma unroll
            for (int n = 0; n < 2; ++n) { w0[n] = bf4(*(const LAS u32x2*)(cwl + c0 + 4 * n)); w1[n] = bf4(*(const LAS u32x2*)(cwl + DFF + c0 + 4 * n)); w2[n] = bf4(*(const LAS u32x2*)(cwl + 2 * DFF + c0 + 4 * n)); bb[n] = bf4(*(const LAS u32x2*)(cwl + 3 * DFF + c0 + 4 * n)); }
#pragma unroll
            for (int ai = 0; ai < 2; ++ai) {
                f32x4 p1[2] = {(f32x4){0.f, 0.f, 0.f, 0.f}, (f32x4){0.f, 0.f, 0.f, 0.f}}, p2[2] = {(f32x4){0.f, 0.f, 0.f, 0.f}, (f32x4){0.f, 0.f, 0.f, 0.f}};
#pragma unroll
                for (int m = 0; m < 4; ++m) {
                    const int row = row0 + ai * 128 + m * 16;
                    float hv[8];
#pragma unroll
                    for (int n = 0; n < 2; ++n) {
                        const f32x4 g = acc[ai][0][m][n], up = acc[ai][1][m][n];
                        f32x4 c1, c2;
#pragma unroll
                        for (int j = 0; j < 4; ++j) {
                            c1[j] = __int_as_float(__builtin_amdgcn_update_dpp(0, __float_as_int(g[j]), 0x121, 0xF, 0xF, false));
                            c2[j] = __int_as_float(__builtin_amdgcn_update_dpp(0, __float_as_int(g[j]), 0x122, 0xF, 0xF, false)); }
                        f32x4 g1v, g2v;
#pragma unroll
                        for (int j = 0; j < 4; ++j) { g1v[j] = fr >= 1 ? c1[j] : p1[n][j]; g2v[j] = fr >= 2 ? c2[j] : p2[n][j]; }
#pragma unroll
                        for (int hh = 0; hh < 2; ++hh) {
                            const f32x2 gg = (f32x2){g[2 * hh], g[2 * hh + 1]}, a1 = (f32x2){g1v[2 * hh], g1v[2 * hh + 1]}, a2 = (f32x2){g2v[2 * hh], g2v[2 * hh + 1]};
                            const f32x2 t0 = (f32x2){w0[n][2 * hh], w0[n][2 * hh + 1]}, t1 = (f32x2){w1[n][2 * hh], w1[n][2 * hh + 1]}, t2 = (f32x2){w2[n][2 * hh], w2[n][2 * hh + 1]};
                            const f32x2 y = t0 * a2 + (t1 * a1 + (t2 * gg + (f32x2){bb[n][2 * hh], bb[n][2 * hh + 1]}));
                            const f32x2 t = y * (-1.4426950408889634f);
                            f32x2 d = (f32x2){__builtin_amdgcn_exp2f(t.x), __builtin_amdgcn_exp2f(t.y)} + 1.0f;
                            d = (f32x2){__builtin_amdgcn_rcpf(d.x), __builtin_amdgcn_rcpf(d.y)};
                            const f32x2 hvv = y * d * (f32x2){up[2 * hh], up[2 * hh + 1]};
                            hv[4 * n + 2 * hh] = hvv.x; hv[4 * n + 2 * hh + 1] = hvv.y;
                        }
                        p1[n] = c1; p2[n] = c2;
                    }
                    *(u32x4*)(o0 + (size_t)row * DFF + c0) = pack8(hv);
                    const int rr = (m & 1) * 16 + fr;
                    if (rr >= 30 || rr < 2) {
                        float* gd = o2 + ((size_t)(row >> 5) * 4 + (rr >= 30 ? rr - 30 : 2 + rr)) * DFF + c0;
                        *(f32x4*)gd = acc[ai][0][m][0]; *(f32x4*)(gd + 4) = acc[ai][0][m][1];
                        if (rr < 2) { float* up_ = ud + ((size_t)(row >> 5) * 2 + rr) * DFF + c0; *(f32x4*)up_ = acc[ai][1][m][0]; *(f32x4*)(up_ + 4) = acc[ai][1][m][1]; }
                    }
                    __builtin_amdgcn_sched_barrier(0);
                }
            }
        } else {
            if (u.pn < t2) {
                bf16_t* base; int ld, colt;
                if (u.pn < t1) { base = o0; ld = ld0; colt = u.pn * 256; } else { base = o1; ld = ld1; colt = (u.pn - t1) * 256; }
                const int col0 = colt + wc * 32 + 8 * fq;
#pragma unroll
                for (int ai = 0; ai < 2; ++ai)
#pragma unroll
                    for (int m = 0; m < 4; ++m) {
                        bf16_t* rowp = base + (size_t)(row0 + ai * 128 + m * 16) * ld + col0;
#pragma unroll
                        for (int bj = 0; bj < 2; ++bj) {
                            const f32x4 v0 = acc[ai][bj][m][0], v1 = acc[ai][bj][m][1];
                            u32x4 w; w.x = pk2(v0[0], v0[1]); w.y = pk2(v0[2], v0[3]); w.z = pk2(v1[0], v1[1]); w.w = pk2(v1[2], v1[3]);
                            *(u32x4*)(rowp + bj * 128) = w;
                        }
                    }
            } else if (wc == 0 && fq < 2) {
#pragma unroll
                for (int ai = 0; ai < 2; ++ai)
#pragma unroll
                    for (int m = 0; m < 4; ++m) {
                        float* rp = o2 + (size_t)(row0 + ai * 128 + m * 16) * 16 + 8 * fq;
                        *(f32x4*)rp = acc[ai][0][m][0]; *(f32x4*)(rp + 4) = acc[ai][0][m][1];
                    }
            }
        }
    }
};

__device__ __forceinline__ void gemm_phase(LAS unsigned char* lds, const bf16_t* A, const bf16_t* Bt, int M, int N, int K, const Epi& E) {
    using namespace pg8;
    int tid_ = tidx(); int bid_ = bidx();
    const int tid = tid_, wid = __builtin_amdgcn_readfirstlane(tid >> 6), lane = tid & 63, wr = wid >> 2, wc = wid & 3, fr = lane & 15, fq = lane >> 4;
    const int nt = K / BK;
    const bool perm = true;
    if (E.mode == 2) {
        LAS bf16_t* cwl = (LAS bf16_t*)(lds + CWL_OFF);
        for (int idx = tid; idx < 4 * DFF; idx += NTHREADS) cwl[idx] = f2bf(idx < 3 * DFF ? E.cw[idx] : E.cb[idx - 3 * DFF]);
        asm volatile("s_waitcnt lgkmcnt(0)" ::: "memory");
    }
    StaticOrder S; S.init(M, N, gridDim.x, bid_);
    unsigned voffA[2], voffB[2];
#pragma unroll
    for (int i = 0; i < 2; ++i) { int R, C; stage_rc(tid * 16 + i * 8192, R, C); const int Rb = perm ? ((R & ~31) + perm32(R & 31)) : R;
        voffA[i] = (unsigned)(R * K + C) * 2u; voffB[i] = (unsigned)(Rb * K + C) * 2u; }
    const size_t kstep = (size_t)(BK * 2);
    const size_t hstep = (size_t)HALF * K * 2;
    const size_t tstep = 2 * hstep;
    const unsigned ldsw = (unsigned)wid * 1024u;
    const int aoff = lds_byte(wr * 64 + fr, fq * 8), boff = lds_byte(wc * 32 + fr, fq * 8);
#define PG8_SA(b, h) (((b) * 2 + (h)) * HTB)
#define PG8_SB(b, h) ((4 + (b) * 2 + (h)) * HTB)
#define PG8_STAGE(bufoff, gbase, voff) do { _Pragma("unroll") for (int _i = 0; _i < 2; ++_i) \
        __builtin_amdgcn_global_load_lds((const unsigned*)((const char*)(gbase) + (voff)[_i]), (LAS unsigned*)(lds + (bufoff) + ldsw + _i * 8192), 16, 0, 0); } while (0)
#define PG8_LDA(dst, b, h) do { _Pragma("unroll") for (int m = 0; m < 4; ++m) _Pragma("unroll") for (int k = 0; k < 2; ++k) dst[m][k] = *(const LAS bf16x8*)(lds + PG8_SA(b, h) + aoff + m * 2048 + k * 1024); } while (0)
#define PG8_LDB(dst, b, h) do { _Pragma("unroll") for (int n = 0; n < 2; ++n) _Pragma("unroll") for (int k = 0; k < 2; ++k) dst[n][k] = *(const LAS bf16x8*)(lds + PG8_SB(b, h) + boff + n * 2048 + k * 1024); } while (0)
#define PG8_MMA(ai, bj, At, Bt_) do { __builtin_amdgcn_s_setprio(1); _Pragma("unroll") for (int m = 0; m < 4; ++m) _Pragma("unroll") for (int n = 0; n < 2; ++n) _Pragma("unroll") for (int k = 0; k < 2; ++k) \
        acc[ai][bj][m][n] = __builtin_amdgcn_mfma_f32_16x16x32_bf16(Bt_[n][k], At[m][k], acc[ai][bj][m][n], 0, 0, 0); __builtin_amdgcn_s_setprio(0); } while (0)
#define PG8_WAIT_V(n) asm volatile("s_waitcnt vmcnt(" #n ")" ::: "memory")
#define PG8_WAIT_L(n) asm volatile("s_waitcnt lgkmcnt(" #n ")" ::: "memory")
#define PG8_BAR __builtin_amdgcn_s_barrier()
#define PG8_SCHED __builtin_amdgcn_sched_barrier(0)
    Unit cur, nxt; int ui = 0;
    if (!S.next(0, cur)) return;
    f32x4 acc[2][2][4][2];
#pragma unroll
    for (int a = 0; a < 2; ++a)
#pragma unroll
        for (int b = 0; b < 2; ++b)
#pragma unroll
            for (int m = 0; m < 4; ++m)
#pragma unroll
                for (int n = 0; n < 2; ++n) acc[a][b][m][n] = (f32x4){0.f, 0.f, 0.f, 0.f};
    bf16x8 At[4][2], B0[2][2], B1[2][2];
    const char* cA = (const char*)A + (size_t)cur.pm * tstep; const char* cB = (const char*)Bt + (size_t)cur.pn * tstep;
    PG8_STAGE(PG8_SB(0, 0), cB, voffB); PG8_STAGE(PG8_SB(0, 1), cB + hstep, voffB); PG8_STAGE(PG8_SA(0, 0), cA, voffA); PG8_STAGE(PG8_SA(0, 1), cA + hstep, voffA);
    if (wr == 1) PG8_BAR;
    PG8_WAIT_V(2); PG8_BAR;
    PG8_STAGE(PG8_SB(1, 0), cB + kstep, voffB); PG8_STAGE(PG8_SA(1, 0), cA + kstep, voffA); PG8_STAGE(PG8_SB(1, 1), cB + hstep + kstep, voffB);
    PG8_WAIT_V(6); PG8_BAR;
    for (;;) {
        const bool has_next = S.next(ui + 1, nxt);
        const char* nA = has_next ? (const char*)A + (size_t)nxt.pm * tstep : cA; const char* nB = has_next ? (const char*)Bt + (size_t)nxt.pn * tstep : cB;
        for (int t = 0; t < nt; t += 2) {
            const bool last = (t == nt - 2);
            const char* a1 = cA + (size_t)(t + 1) * kstep;
            const char* a2 = last ? nA : cA + (size_t)(t + 2) * kstep; const char* b2 = last ? nB : cB + (size_t)(t + 2) * kstep;
            const char* a3 = a2 + kstep; const char* b3 = b2 + kstep;
            PG8_LDB(B0, 0, 0); PG8_LDB(B1, 0, 1); PG8_SCHED; PG8_LDA(At, 0, 0); PG8_STAGE(PG8_SA(1, 1), a1 + hstep, voffA);
            PG8_WAIT_V(8); PG8_WAIT_L(0); PG8_BAR; PG8_MMA(0, 0, At, B0); PG8_MMA(0, 1, At, B1); PG8_BAR; PG8_SCHED;
            PG8_LDA(At, 0, 1); PG8_STAGE(PG8_SB(0, 0), b2, voffB); PG8_STAGE(PG8_SB(0, 1), b2 + hstep, voffB); PG8_STAGE(PG8_SA(0, 0), a2, voffA);
            PG8_WAIT_V(8); PG8_WAIT_L(0); PG8_BAR; PG8_MMA(1, 0, At, B0); PG8_MMA(1, 1, At, B1); PG8_BAR; PG8_SCHED;
            PG8_LDB(B0, 1, 0); PG8_LDB(B1, 1, 1); PG8_SCHED; PG8_LDA(At, 1, 0); PG8_STAGE(PG8_SA(0, 1), a2 + hstep, voffA);
            PG8_WAIT_V(8); PG8_WAIT_L(0); PG8_BAR; PG8_MMA(0, 0, At, B0); PG8_MMA(0, 1, At, B1); PG8_BAR; PG8_SCHED;
            PG8_LDA(At, 1, 1); PG8_STAGE(PG8_SB(1, 0), b3, voffB); PG8_STAGE(PG8_SB(1, 1), b3 + hstep, voffB); PG8_STAGE(PG8_SA(1, 0), a3, voffA);
            PG8_WAIT_V(8); PG8_WAIT_L(0); PG8_BAR; PG8_MMA(1, 0, At, B0); PG8_MMA(1, 1, At, B1); PG8_BAR; PG8_SCHED;
        }
        if (wr == 0) PG8_BAR;
        E(acc, cur, wr, wc, fr, fq);
        if (!has_next) break;
#pragma unroll
        for (int a = 0; a < 2; ++a)
#pragma unroll
            for (int b = 0; b < 2; ++b)
#pragma unroll
                for (int m = 0; m < 4; ++m)
#pragma unroll
                    for (int n = 0; n < 2; ++n) acc[a][b][m][n] = (f32x4){0.f, 0.f, 0.f, 0.f};
        cur = nxt; cA = nA; cB = nB; ++ui;
        if (wr == 1) PG8_BAR;
    }
    PG8_WAIT_V(0);
    PG8_BAR;
#undef PG8_SA
#undef PG8_SB
#undef PG8_STAGE
#undef PG8_LDA
#undef PG8_LDB
#undef PG8_MMA
#undef PG8_WAIT_V
#undef PG8_WAIT_L
#undef PG8_BAR
#undef PG8_SCHED
}

__device__ __forceinline__ void transpose_item(const float* W, int ldw, int K, int nblk, bf16_t* WT, LAS float* scr, int item, int lane, bool ffn_il = false) {
    const int kb = item / nblk, nb = item % nblk, k0 = 64 * kb, n0 = 32 * nb;
    const int d0 = !ffn_il ? n0 : (n0 < DFF ? 256 * (n0 >> 7) + (n0 & 127) : 256 * ((n0 - DFF) >> 7) + 128 + ((n0 - DFF) & 127));
#pragma unroll 8
    for (int i = 0; i < 32; ++i) { const int kk = 2 * i + (lane >> 5); scr[kk * 33 + (lane & 31)] = W[(size_t)(k0 + kk) * ldw + n0 + (lane & 31)]; }
    asm volatile("s_waitcnt lgkmcnt(0)" ::: "memory");
    const int c = lane & 7;
#pragma unroll
    for (int j = 0; j < 4; ++j) { const int n = (lane >> 3) + 8 * j; const LAS float* s = scr + (8 * c) * 33 + n;
        u32x4 o; o.x = pk2(s[0 * 33], s[1 * 33]); o.y = pk2(s[2 * 33], s[3 * 33]); o.z = pk2(s[4 * 33], s[5 * 33]); o.w = pk2(s[6 * 33], s[7 * 33]);
        *(u32x4*)(WT + (size_t)(d0 + n) * K + k0 + 8 * c) = o; }
    asm volatile("s_waitcnt lgkmcnt(0)" ::: "memory");
}

__device__ __forceinline__ void transpose_item64(const float* W, int ldw, int K, int nblk, bf16_t* WT, LAS float* scr, int item, int lane, bool ffn_il = false) {
    const int kb = item / nblk, nb = item % nblk, k0 = 64 * kb, n0 = 64 * nb;
    const int d0 = !ffn_il ? n0 : (n0 < DFF ? 256 * (n0 >> 7) + (n0 & 127) : 256 * ((n0 - DFF) >> 7) + 128 + ((n0 - DFF) & 127));
    const int c4 = (lane & 15) * 4, kq = lane >> 4;
    f32x4 v[16];
#pragma unroll
    for (int i = 0; i < 16; ++i) v[i] = *(const f32x4*)(W + (size_t)(k0 + 4 * i + kq) * ldw + n0 + c4);
#pragma unroll
    for (int i = 0; i < 16; ++i) { LAS float* d = scr + (4 * i + kq) * 65 + c4; d[0] = v[i].x; d[1] = v[i].y; d[2] = v[i].z; d[3] = v[i].w; }
    asm volatile("s_waitcnt lgkmcnt(0)" ::: "memory");
    const int c = lane & 7;
#pragma unroll
    for (int j = 0; j < 8; ++j) { const int n = (lane >> 3) + 8 * j; const LAS float* s = scr + (8 * c) * 65 + n;
        u32x4 o; o.x = pk2(s[0 * 65], s[1 * 65]); o.y = pk2(s[2 * 65], s[3 * 65]); o.z = pk2(s[4 * 65], s[5 * 65]); o.w = pk2(s[6 * 65], s[7 * 65]);
        *(u32x4*)(WT + (size_t)(d0 + n) * K + k0 + 8 * c) = o; }
    asm volatile("s_waitcnt lgkmcnt(0)" ::: "memory");
}

__device__ __forceinline__ void prep_phase(const Args& a, LAS unsigned char* lds) {
    const int tid = tidx(), lane = tid & 63, wave = tid >> 6;
    bf16_t* WT = (bf16_t*)(a.ws + WS_WT);
    if (bidx() < 192) {
        const int bb = bidx(), l = bb / 48, cl = tid & 127, cq = tid >> 7, n = (bb % 48) * 128 + cl;
        LAS float* cs = (LAS float*)lds;
        LAS float* red = (LAS float*)(lds + 49152);
        float acc[48];
#pragma unroll
        for (int s = 0; s < 48; ++s) acc[s] = 0.f;
        const float* w = a.in[11] + (size_t)l * 1024 * 6144 + n;
        for (int kc = 0; kc < 4; ++kc) {
            __syncthreads();
            for (int idx = tid; idx < 48 * 256; idx += NTHREADS) { const int s = idx >> 8, k = idx & 255;
                const float c = s < 32 ? a.in[2][s * 1024 + kc * 256 + k] : a.in[3][(s - 32) * 1024 + kc * 256 + k];
                cs[k * 48 + s] = siluf(c); }
            __syncthreads();
#pragma unroll 1
            for (int k8 = 0; k8 < 64; k8 += 8) {
                float wv[8];
#pragma unroll
                for (int u = 0; u < 8; ++u) wv[u] = w[(size_t)(kc * 256 + cq * 64 + k8 + u) * 6144];
#pragma unroll
                for (int u = 0; u < 8; ++u) {
                    const LAS f32x4* cp = (const LAS f32x4*)(cs + (cq * 64 + k8 + u) * 48);
#pragma unroll
                    for (int s4 = 0; s4 < 12; ++s4) { const f32x4 c = cp[s4]; acc[4 * s4] += c.x * wv[u]; acc[4 * s4 + 1] += c.y * wv[u]; acc[4 * s4 + 2] += c.z * wv[u]; acc[4 * s4 + 3] += c.w * wv[u]; }
                }
            }
        }
#pragma unroll
        for (int s = 0; s < 48; ++s) red[(cq * 48 + s) * 128 + cl] = acc[s];
        __syncthreads();
        float* mod = (float*)(a.ws + WS_MOD) + (size_t)l * 48 * 6144 + (bb % 48) * 128;
        for (int idx = tid; idx < 48 * 128; idx += NTHREADS) { const int s = idx >> 7, c = idx & 127;
            mod[(size_t)s * 6144 + c] = red[(0 * 48 + s) * 128 + c] + red[(1 * 48 + s) * 128 + c] + red[(2 * 48 + s) * 128 + c] + red[(3 * 48 + s) * 128 + c] + a.in[12][l * 6144 + (bb % 48) * 128 + c]; }
        __syncthreads();
    }
    {
        LAS float* scr = (LAS float*)(lds + wave * 16640);
        const int gw = bidx() * 8 + wave, NGW = gridDim.x * 8;
        constexpr int I_GIN = 16 * 64, I_SQ = 16 * 16, I_MIN = 16 * 21, I_QUP = 6 * 24, I_KVUP = 4 * 32, I_SIN = 16 * 24, I_FIN = 16 * 88, I_FOUT = 44 * 16;
        constexpr int NITEMS = 2 * I_GIN + 2 * I_SQ + I_MIN + I_QUP + I_KVUP + I_SQ + I_SIN + I_SQ + 4 * I_FIN + 4 * I_FOUT;
        for (int it = gw; it < NITEMS; it += NGW) {
            int r = it;
            if (r < 4 * I_FIN) { const int s = r / I_FIN; transpose_item64(a.in[32] + (size_t)s * 1024 * 5632, 5632, 1024, 88, WT + WT_FIN + (size_t)s * 5632 * 1024, scr, r % I_FIN, lane, true); continue; } r -= 4 * I_FIN;
            if (r < 4 * I_FOUT) { const int s = r / I_FOUT; transpose_item64(a.in[35] + (size_t)s * 2816 * 1024, 1024, 2816, 16, WT + WT_FOUT + (size_t)s * 1024 * 2816, scr, r % I_FOUT, lane); continue; } r -= 4 * I_FOUT;
            if (r < 2 * I_GIN) { const int s = r / I_GIN; transpose_item64(a.in[16] + (size_t)s * 1024 * 4112, 4112, 1024, 64, WT + WT_GIN + (size_t)s * 4352 * 1024, scr, r % I_GIN, lane); continue; } r -= 2 * I_GIN;
            if (r < 2 * I_SQ) { const int s = r / I_SQ; transpose_item64(a.in[21] + (size_t)s * 1024 * 1024, 1024, 1024, 16, WT + WT_GO + (size_t)s * 1024 * 1024, scr, r % I_SQ, lane); continue; } r -= 2 * I_SQ;
            if (r < I_MIN) { transpose_item(a.in[22], 672, 1024, 21, WT + WT_MIN, scr, r, lane); continue; } r -= I_MIN;
            if (r < I_QUP) { transpose_item64(a.in[25], 1536, 384, 24, WT + WT_QUP, scr, r, lane); continue; } r -= I_QUP;
            if (r < I_KVUP) { transpose_item64(a.in[26], 2048, 256, 32, WT + WT_KVUP, scr, r, lane); continue; } r -= I_KVUP;
            if (r < I_SQ) { transpose_item64(a.in[27], 1024, 1024, 16, WT + WT_MO, scr, r, lane); continue; } r -= I_SQ;
            if (r < I_SIN) { transpose_item64(a.in[28], 1536, 1024, 24, WT + WT_SIN, scr, r, lane); continue; } r -= I_SIN;
            transpose_item64(a.in[30], 1024, 1024, 16, WT + WT_SO, scr, r, lane);
        }
    }
    const size_t gt = (size_t)bidx() * NTHREADS + tid, NGT = (size_t)gridDim.x * NTHREADS;
    for (size_t i = gt; i < 2ull * 256 * 1024; i += NGT) { const int s = (int)(i / (256 * 1024)), rr = (int)((i / 1024) % 256), k = (int)(i % 1024);
        const float v = rr < 16 ? a.in[16][(size_t)s * 1024 * 4112 + (size_t)k * 4112 + 4096 + rr] : 0.f;
        WT[WT_GIN + (size_t)s * 4352 * 1024 + (size_t)(4096 + rr) * 1024 + k] = f2bf(v); }
    for (size_t i = gt; i < 96ull * 1024; i += NGT) WT[WT_MIN + 672ull * 1024 + i] = 0;
    { f32x2* rope = (f32x2*)(a.ws + WS_ROPE);
      for (size_t i = gt; i < 2048ull * 16; i += NGT) { const int pos = (int)(i >> 4), j = (int)(i & 15);
          const float inv = powf(10000.f, -(float)j / 16.f); const float ang = (float)pos * inv; rope[i] = (f32x2){cosf(ang), sinf(ang)}; } }
    { float* bt = (float*)(a.ws + WS_BIAS);
      for (size_t i = gt; i < 16ull * 256; i += NGT) { const int h = (int)(i >> 8), idx = (int)(i & 255); const int n = idx - 63; const int an = n < 0 ? -n : n;
          int bucket = (n < 0 ? 16 : 0);
          if (an < 8) bucket += an; else { int lb = 8 + (31 - __clz(an * an)) - 6; bucket += lb < 15 ? lb : 15; }
          bt[i] = a.in[31][bucket * 16 + h] * 1.4426950408889634f; } }
    { bf16_t* kc = (bf16_t*)(a.ws + WS_SWAKC); bf16_t* vc = (bf16_t*)(a.ws + WS_SWAVC);
      for (size_t i = gt; i < 16ull * 128 * 256; i += NGT) { kc[i] = f2bf(a.in[8][i]); vc[i] = f2bf(a.in[9][i]); } }
}

__device__ __forceinline__ void norm_phase(const Args& a, bool from_input, const float* gain, int layer, int shidx) {
    const int lane = tidx() & 63, gw = bidx() * 8 + (tidx() >> 6), NGW = gridDim.x * 8;
    const float* X = a.out; bf16_t* H = (bf16_t*)(a.ws + WS_H);
    const float* mod = (const float*)(a.ws + WS_MOD) + (size_t)layer * 48 * 6144;
    f32x4 g[4];
#pragma unroll
    for (int j = 0; j < 4; ++j) g[j] = *(const f32x4*)(gain + 4 * lane + 256 * j);
#pragma unroll 1
    for (int row0 = gw * 4; row0 < MT; row0 += NGW * 4) {
        f32x4 v[4][4];
        if (from_input) {
            const float* xr = row0 < NTP ? a.in[0] + (size_t)row0 * D : a.in[1] + (size_t)(row0 - NTP) * D;
#pragma unroll
            for (int rr = 0; rr < 4; ++rr)
#pragma unroll
                for (int j = 0; j < 4; ++j) v[rr][j] = *(const f32x4*)(xr + (size_t)rr * D + 4 * lane + 256 * j);
        } else {
            const bf16_t* xr = (const bf16_t*)X + (size_t)row0 * XS;
            u32x2 t[4][4];
#pragma unroll
            for (int rr = 0; rr < 4; ++rr)
#pragma unroll
                for (int j = 0; j < 4; ++j) t[rr][j] = *(const u32x2*)(xr + (size_t)rr * XS + 4 * lane + 256 * j);
#pragma unroll
            for (int rr = 0; rr < 4; ++rr)
#pragma unroll
                for (int j = 0; j < 4; ++j) v[rr][j] = (f32x4){__uint_as_float(t[rr][j].x << 16), __uint_as_float(t[rr][j].x & 0xFFFF0000u), __uint_as_float(t[rr][j].y << 16), __uint_as_float(t[rr][j].y & 0xFFFF0000u)};
        }
        const float* mp = mod + (size_t)seq_of(row0) * 6144 + shidx * 1024;
        f32x4 sh[4], sc[4];
#pragma unroll
        for (int j = 0; j < 4; ++j) { sh[j] = *(const f32x4*)(mp + 4 * lane + 256 * j); sc[j] = g[j] * (*(const f32x4*)(mp + 1024 + 4 * lane + 256 * j) + 1.f); }
#pragma unroll
        for (int rr = 0; rr < 4; ++rr) {
            float ss = 0.f;
#pragma unroll
            for (int j = 0; j < 4; ++j) ss += v[rr][j].x * v[rr][j].x + v[rr][j].y * v[rr][j].y + v[rr][j].z * v[rr][j].z + v[rr][j].w * v[rr][j].w;
#pragma unroll
            for (int o = 1; o < 64; o <<= 1) ss += __shfl_xor(ss, o);
            const float rstd = rsqrtf(ss * (1.f / D) + EPS);
#pragma unroll
            for (int j = 0; j < 4; ++j) {
                const f32x4 y = v[rr][j] * rstd * sc[j] + sh[j];
                u32x2 o; o.x = pk2(y.x, y.y); o.y = pk2(y.z, y.w);
                *(u32x2*)(H + (size_t)(row0 + rr) * D + 4 * lane + 256 * j) = o;
            }
        }
    }
}

__device__ __forceinline__ void final_norm_phase(const Args& a) {
    const int lane = tidx() & 63, gw = bidx() * 8 + (tidx() >> 6), NGW = gridDim.x * 8;
    f32x4 g[4];
#pragma unroll
    for (int j = 0; j < 4; ++j) g[j] = *(const f32x4*)(a.in[15] + 4 * lane + 256 * j);
#pragma unroll 1
    for (int row0 = gw * 4; row0 < MT; row0 += NGW * 4) {
        float* xr = a.out + (size_t)row0 * D;
        f32x4 v[4][4];
        {
            const bf16_t* xb = (const bf16_t*)a.out + (size_t)row0 * XS;
            u32x2 t[4][4];
#pragma unroll
            for (int rr = 0; rr < 4; ++rr)
#pragma unroll
                for (int j = 0; j < 4; ++j) t[rr][j] = *(const u32x2*)(xb + (size_t)rr * XS + 4 * lane + 256 * j);
#pragma unroll
            for (int rr = 0; rr < 4; ++rr)
#pragma unroll
                for (int j = 0; j < 4; ++j) v[rr][j] = (f32x4){__uint_as_float(t[rr][j].x << 16), __uint_as_float(t[rr][j].x & 0xFFFF0000u), __uint_as_float(t[rr][j].y << 16), __uint_as_float(t[rr][j].y & 0xFFFF0000u)};
        }
        asm volatile("s_waitcnt vmcnt(0)" ::: "memory");
#pragma unroll
        for (int rr = 0; rr < 4; ++rr) {
            float ss = 0.f;
#pragma unroll
            for (int j = 0; j < 4; ++j) ss += v[rr][j].x * v[rr][j].x + v[rr][j].y * v[rr][j].y + v[rr][j].z * v[rr][j].z + v[rr][j].w * v[rr][j].w;
#pragma unroll
            for (int o = 1; o < 64; o <<= 1) ss += __shfl_xor(ss, o);
            const float rstd = rsqrtf(ss * (1.f / D) + EPS);
#pragma unroll
            for (int j = 0; j < 4; ++j) *(f32x4*)(xr + (size_t)rr * D + 4 * lane + 256 * j) = v[rr][j] * rstd * g[j];
        }
    }
}

__device__ __forceinline__ void gdn_row16(const bf16_t* QKV, const float* hist, bool samp, size_t row0, int tt, int col0, float* x) {
    if (tt >= 0) { const bf16_t* p = QKV + (row0 + tt) * 3072 + col0; unpack8(*(const u32x4*)p, x); unpack8(*(const u32x4*)(p + 8), x + 8); }
    else if (samp) { const float* p = hist + (size_t)(3 + tt) * 3072 + col0;
#pragma unroll
        for (int e = 0; e < 16; e += 4) { const f32x4 v = *(const f32x4*)(p + e); x[e] = v.x; x[e + 1] = v.y; x[e + 2] = v.z; x[e + 3] = v.w; } }
    else {
#pragma unroll
        for (int e = 0; e < 16; ++e) x[e] = 0.f; }
}

__device__ __forceinline__ void gdn_pre_phase(const Args& a, LAS unsigned char* lds, int slot) {
    const int tid0 = tidx();
    const int lane0 = tid0 & 63, wave = __builtin_amdgcn_readfirstlane(tid0 >> 6);
#define G1_LANEVARS int lane = lane0; OPAQUE_V(lane); const int r = lane & 15, quad = lane >> 4; (void)r; (void)quad;
    LAS unsigned char* wl = lds + wave * 18736;
    LAS bf16_t* Ks = (LAS bf16_t*)wl;
    LAS float* AT = (LAS float*)wl;
    LAS float* GCs = (LAS float*)(wl + 18224); LAS float* BEs = GCs + 64;
    const bf16_t* QKV = (const bf16_t*)(a.ws + BG_QKV); const float* AB = (const float*)(a.ws + BG_AB);
    bf16_t* Hq = (bf16_t*)(a.ws + WS_H); bf16_t* KN = (bf16_t*)(a.ws + BG_KN); bf16_t* TB = (bf16_t*)(a.ws + BG_TB); float* GB = (float*)(a.ws + BG_GB);
    const float* convw = a.in[17] + (size_t)slot * 4 * 3072;

    for (size_t i = (size_t)bidx() * NTHREADS + tid0; i < 48ull * 3 * 3072; i += (size_t)gridDim.x * NTHREADS) {
        const int s = (int)(i / (3 * 3072)), j = (int)((i / 3072) % 3), c = (int)(i % 3072);
        if (s < 32) a.out[O_GCP + ((size_t)(slot * 32 + s) * 3 + j) * 3072 + c] = bf2f(QKV[((size_t)s * 2048 + 2045 + j) * 3072 + c]);
        else a.out[O_GCS + ((size_t)(slot * 16 + s - 32) * 3 + j) * 3072 + c] = bf2f(QKV[((size_t)NTP + (s - 32) * 32 + 29 + j) * 3072 + c]);
    }

    const int gw = wave * gridDim.x + bidx(), NGW = gridDim.x * 8;
#pragma unroll 1
    for (int item = gw; item < 8320; item += NGW) {
        const bool samp = item >= 8192;
        int b, h, t0, R; size_t row0;
        if (!samp) { const int sc = item >> 3; h = item & 7; b = sc >> 5; t0 = (sc & 31) * 64; row0 = (size_t)b * 2048; R = 64; }
        else { const int it = item - 8192; b = it >> 3; h = it & 7; t0 = 0; row0 = (size_t)NTP + b * 32; R = 32; }
        const float* hist = a.in[4] + (size_t)(slot * 16 + b) * 3 * 3072;
        {
            G1_LANEVARS
            float g = 0.f, be = 0.f;
            if (lane < R) {
                const float av = AB[(row0 + t0 + lane) * 16 + h] + a.in[19][slot * 8 + h], bv = AB[(row0 + t0 + lane) * 16 + 8 + h];
                const float sp = av > 20.f ? av : log1pf(__expf(av));
                g = -__expf(a.in[18][slot * 8 + h]) * sp; be = sigmoidf_(bv);
            }
            float x = g;
#pragma unroll
            for (int o = 1; o < 64; o <<= 1) { const float y = __shfl_up(x, o); if (lane >= o) x += y; }
            GCs[lane] = x; BEs[lane] = be;
            GB[(size_t)item * 128 + lane] = x; GB[(size_t)item * 128 + 64 + lane] = be;
        }
        {
            G1_LANEVARS
            const int sub = lane & 7, il = lane >> 3; const int Tlen = samp ? 32 : 2048;
            auto load_raw = [&](int part, u32x4 (&rg)[17]) {
#pragma unroll
                for (int n = 0; n < 17; ++n) {
                    const int idx = lane + 64 * n, row = idx >> 4, ch = idx & 15, tt = t0 - 3 + row;
                    rg[n] = (u32x4){0u, 0u, 0u, 0u};
                    if (idx < 1072 && tt < Tlen) {
                        if (tt >= 0) rg[n] = *(const u32x4*)(QKV + (row0 + tt) * 3072 + part * 1024 + h * 128 + ch * 8);
                        else if (samp) { const float* p = hist + (size_t)(3 + tt) * 3072 + part * 1024 + h * 128 + ch * 8; const f32x4 v0 = *(const f32x4*)p, v1 = *(const f32x4*)(p + 4);
                            rg[n] = (u32x4){pk2(v0.x, v0.y), pk2(v0.z, v0.w), pk2(v1.x, v1.y), pk2(v1.z, v1.w)}; }
                    }
                }
            };
            auto store_raw = [&](const u32x4 (&rg)[17]) {
#pragma unroll
                for (int n = 0; n < 17; ++n) { const int idx = lane + 64 * n, row = idx >> 4, ch = idx & 15; if (idx < 1072) *(LAS u32x4*)(Ks + row * 136 + ch * 8) = rg[n]; }
            };
            u32x4 rq[17], rk[17];
            load_raw(0, rq);
            store_raw(rq);
            asm volatile("s_waitcnt lgkmcnt(0)" ::: "memory");
            load_raw(1, rk);
#pragma unroll 1
            for (int part = 0; part < 2; ++part) {
                const int col0 = part * 1024 + h * 128 + sub * 16;
                f32x2 cw[4][8];
#pragma unroll
                for (int j = 0; j < 4; ++j)
#pragma unroll
                    for (int e = 0; e < 16; e += 4) { const f32x4 wv = *(const f32x4*)(convw + j * 3072 + col0 + e); cw[j][e / 2] = (f32x2){wv.x, wv.y}; cw[j][e / 2 + 1] = (f32x2){wv.z, wv.w}; }
                if (part == 1) { asm volatile("s_waitcnt lgkmcnt(0)" ::: "memory"); store_raw(rk); asm volatile("s_waitcnt lgkmcnt(0)" ::: "memory"); }
#pragma unroll 1
                for (int tg = 0; tg < 8; ++tg) {
                    const int i = tg * 8 + il; const bool valid = i < R;
                    f32x2 y[8];
#pragma unroll
                    for (int k = 0; k < 8; ++k) y[k] = (f32x2){0.f, 0.f};
#pragma unroll
                    for (int j = 0; j < 4; ++j) { const LAS bf16_t* rp = Ks + (i + j) * 136 + sub * 16;
                        const u32x4 xa = *(const LAS u32x4*)rp, xb = *(const LAS u32x4*)(rp + 8);
                        const unsigned xw[8] = {xa.x, xa.y, xa.z, xa.w, xb.x, xb.y, xb.z, xb.w};
#pragma unroll
                        for (int k = 0; k < 8; ++k) { const f32x2 xv = (f32x2){__uint_as_float(xw[k] << 16), __uint_as_float(xw[k] & 0xFFFF0000u)}; y[k] = cw[j][k] * xv + y[k]; } }
                    f32x2 ss2 = (f32x2){0.f, 0.f};
#pragma unroll
                    for (int k = 0; k < 8; ++k) {
                        const f32x2 t = y[k] * (-1.4426950408889634f);
                        f32x2 d = (f32x2){__builtin_amdgcn_exp2f(t.x), __builtin_amdgcn_exp2f(t.y)} + 1.0f;
                        d = (f32x2){__builtin_amdgcn_rcpf(d.x), __builtin_amdgcn_rcpf(d.y)};
                        y[k] = valid ? y[k] * d : (f32x2){0.f, 0.f};
                        ss2 = y[k] * y[k] + ss2;
                    }
                    float ss = ss2.x + ss2.y;
                    ss += __shfl_xor(ss, 1); ss += __shfl_xor(ss, 2); ss += __shfl_xor(ss, 4);
                    const float rn = rsqrtf(ss + EPS) * (part == 0 ? 0.08838834764831845f : 1.f);
                    u32x4 p0, p1;
                    { unsigned pw[8];
#pragma unroll
                      for (int k = 0; k < 8; ++k) { const f32x2 z = y[k] * rn; pw[k] = pk2(z.x, z.y); }
                      p0 = (u32x4){pw[0], pw[1], pw[2], pw[3]}; p1 = (u32x4){pw[4], pw[5], pw[6], pw[7]}; }
                    const size_t go = (row0 + t0 + i) * 1024 + h * 128 + sub * 16;
                    if (part == 0) { if (valid) { *(u32x4*)(Hq + go) = p0; *(u32x4*)(Hq + go + 8) = p1; } }
                    else { asm volatile("s_waitcnt lgkmcnt(0)" ::: "memory");
                           *(LAS u32x4*)(Ks + i * 136 + sub * 16) = p0; *(LAS u32x4*)(Ks + i * 136 + sub * 16 + 8) = p1;
                           if (valid) { *(u32x4*)(KN + go) = p0; *(u32x4*)(KN + go + 8) = p1; } }
                }
            }
        }
        {
            G1_LANEVARS
            f32x4 kk[10];
#pragma unroll
            for (int rb = 0; rb < 4; ++rb)
#pragma unroll
                for (int cb = 0; cb <= rb; ++cb) kk[rb * (rb + 1) / 2 + cb] = mm16(Ks + rb * 16 * 136, 136, Ks + cb * 16 * 136, 136, 128, (f32x4){0.f, 0.f, 0.f, 0.f}, lane);
            asm volatile("s_waitcnt lgkmcnt(0)" ::: "memory");
#pragma unroll
            for (int rb = 0; rb < 4; ++rb)
#pragma unroll
                for (int cb = 0; cb <= rb; ++cb) {
                    const int j = cb * 16 + r; const float gj = GCs[j];
#pragma unroll
                    for (int jj = 0; jj < 4; ++jj) { const int i = rb * 16 + quad * 4 + jj;
                        AT[i * 65 + j] = (i > j) ? BEs[i] * kk[rb * (rb + 1) / 2 + cb][jj] * __expf(GCs[i] - gj) : 0.f; }
                }
            asm volatile("s_waitcnt lgkmcnt(0)" ::: "memory");
        }
        {
            G1_LANEVARS
            const int base = quad * 16, cc = r;
            for (int i = 1; i < 16; ++i) {
                float tacc = 0.f;
                for (int j = 0; j < i; ++j) {
                    const float aij = AT[(base + i) * 65 + base + j];
                    const float tj = (j > cc) ? AT[(base + j) * 65 + base + cc] : (j == cc ? 1.f : 0.f);
                    tacc -= aij * tj;
                }
                asm volatile("s_waitcnt lgkmcnt(0)" ::: "memory");
                if (cc < i) AT[(base + i) * 65 + base + cc] = tacc;
                asm volatile("s_waitcnt lgkmcnt(0)" ::: "memory");
            }
#pragma unroll 1
            for (int lev = 1; lev < 4; ++lev)
#pragma unroll 1
                for (int bb = 0; bb < 4 - lev; ++bb) {
                    const int aa = bb + lev, q4 = quad * 4;
                    float mv[4] = {0.f, 0.f, 0.f, 0.f};
                    for (int cb = bb; cb < aa; ++cb) {
                        for (int k = 0; k < 16; ++k) {
                            float tk;
                            if (cb == bb) tk = (cc < k) ? AT[(bb * 16 + k) * 65 + bb * 16 + cc] : (cc == k ? 1.f : 0.f);
                            else tk = AT[(bb * 16 + k) * 65 + cb * 16 + cc];
#pragma unroll
                            for (int jj = 0; jj < 4; ++jj) mv[jj] += AT[(aa * 16 + q4 + jj) * 65 + cb * 16 + k] * tk;
                        }
                    }
                    asm volatile("s_waitcnt lgkmcnt(0)" ::: "memory");
#pragma unroll
                    for (int jj = 0; jj < 4; ++jj) AT[(bb * 16 + q4 + jj) * 65 + aa * 16 + cc] = mv[jj];
                    asm volatile("s_waitcnt lgkmcnt(0)" ::: "memory");
                    float tv[4] = {mv[0], mv[1], mv[2], mv[3]};
                    for (int k = 0; k < 16; ++k) {
                        const float mk = AT[(bb * 16 + k) * 65 + aa * 16 + cc];
#pragma unroll
                        for (int jj = 0; jj < 4; ++jj) { const int ii = q4 + jj; const float dv = AT[(aa * 16 + ii) * 65 + aa * 16 + k]; if (k < ii) tv[jj] += dv * mk; }
                    }
                    asm volatile("s_waitcnt lgkmcnt(0)" ::: "memory");
#pragma unroll
                    for (int jj = 0; jj < 4; ++jj) AT[(bb * 16 + q4 + jj) * 65 + aa * 16 + cc] = -tv[jj];
                    asm volatile("s_waitcnt lgkmcnt(0)" ::: "memory");
                }
        }
        {
            G1_LANEVARS
            const int i = lane, ba = i >> 4;
#pragma unroll 1
            for (int c8 = 0; c8 < 8; ++c8) {
                const int bc = c8 >> 1; float tv[8];
#pragma unroll
                for (int k = 0; k < 8; ++k) { const int cc = c8 * 8 + k;
                    tv[k] = ba == bc ? (cc < i ? AT[i * 65 + cc] : (cc == i ? 1.f : 0.f)) : (ba > bc ? AT[(bc * 16 + (i & 15)) * 65 + ba * 16 + (cc & 15)] : 0.f); }
                *(u32x4*)(TB + (size_t)item * 4096 + i * 64 + c8 * 8) = pack8(tv);
            }
        }
        asm volatile("s_waitcnt lgkmcnt(0)" ::: "memory");
    }
}

__device__ __forceinline__ void gdn_phase(const Args& a, LAS unsigned char* lds, int slot) {
    constexpr int QS_O = 0, KS_O = 17408, KTS_O = 34816, VS_O = 53248, STS_O = 71680, TS_O = 106496, QKS_O = 115712, PTS_O = 124928, GT_O = 143360, CW_O = 145408;
    LAS bf16_t* Qs = (LAS bf16_t*)(lds + QS_O);
    LAS bf16_t* Ks = (LAS bf16_t*)(lds + KS_O);
    LAS bf16_t* KTs = (LAS bf16_t*)(lds + KTS_O);
    LAS bf16_t* Vs = (LAS bf16_t*)(lds + VS_O);
    LAS bf16_t* UGs = (LAS bf16_t*)(lds + VS_O);
    LAS bf16_t* STs = (LAS bf16_t*)(lds + STS_O);
    LAS bf16_t* Ts = (LAS bf16_t*)(lds + TS_O);
    LAS bf16_t* QKs = (LAS bf16_t*)(lds + QKS_O);
    LAS bf16_t* PTs = (LAS bf16_t*)(lds + PTS_O);
    LAS bf16_t* UTs = PTs;
    LAS float* Os = (LAS float*)(lds + QS_O);
    LAS float* GC = (LAS float*)(lds + GT_O);
    LAS float* BETA = GC + 64;
    LAS float* CW = (LAS float*)(lds + CW_O);

    const int tid0 = tidx();
#define GDN_LANEVARS int tid = tid0; OPAQUE_V(tid); const int lane = tid & 63, w = __builtin_amdgcn_readfirstlane(tid >> 6), r = lane & 15, quad = lane >> 4; (void)lane; (void)w; (void)r; (void)quad;
    const bf16_t* QKV = (const bf16_t*)(a.ws + BG_QKV); const bf16_t* Z = (const bf16_t*)(a.ws + BG_Z);
    const bf16_t* KN = (const bf16_t*)(a.ws + BG_KN); const bf16_t* TB = (const bf16_t*)(a.ws + BG_TB); const float* GB = (const float*)(a.ws + BG_GB);
    bf16_t* Hb = (bf16_t*)(a.ws + WS_H);
    const float* convw = a.in[17] + (size_t)slot * 4 * 3072;
    const float* onorm = a.in[20] + slot * 128;

#pragma unroll 1
    for (int item = bidx(); item < 256 + 128; item += gridDim.x) {
        const bool samp = item >= 256;
        const int it = samp ? item - 256 : item, b = it >> 3, h = it & 7;
        const int nch = samp ? 1 : 32, R = samp ? 32 : 64;
        const size_t row0 = samp ? (size_t)NTP + b * 32 : (size_t)b * 2048;
        const float* hist = a.in[4] + (size_t)(slot * 16 + b) * 3 * 3072;
        const int ci0 = samp ? 8192 + b * 8 + h : (b * 32) * 8 + h;
        f32x4 S[8];
        __syncthreads();
        { GDN_LANEVARS
        if (samp) {
            const float* s0 = a.in[5] + ((size_t)(slot * 16 + b) * 8 + h) * 16384;
#pragma unroll
            for (int dt = 0; dt < 8; ++dt)
#pragma unroll
                for (int jj = 0; jj < 4; ++jj) { S[dt][jj] = s0[(dt * 16 + quad * 4 + jj) * 128 + w * 16 + r]; __builtin_amdgcn_sched_barrier(0); }
        } else {
#pragma unroll
            for (int dt = 0; dt < 8; ++dt) S[dt] = (f32x4){0.f, 0.f, 0.f, 0.f};
        }
#pragma unroll
        for (int dt = 0; dt < 8; ++dt) { u32x2 o; o.x = pk2(S[dt][0], S[dt][1]); o.y = pk2(S[dt][2], S[dt][3]); *(LAS u32x2*)(STs + (w * 16 + r) * 136 + dt * 16 + quad * 4) = o; }
        CW[tid] = convw[(tid >> 7) * 3072 + 2048 + h * 128 + (tid & 127)];
        }
        u32x4 pq0, pq1, pk0, pk1, pz0, pz1, pt, pv[8]; float pg = 0.f;
        u32x4 zc0 = (u32x4){0u, 0u, 0u, 0u}, zc1 = zc0;
        auto fetch = [&](int c) {
            int tid = tid0; OPAQUE_V(tid);
            const int i = tid >> 3, sub = tid & 7; const bool valid = i < R;
            const size_t go = (row0 + c * 64 + i) * 1024 + h * 128 + sub * 16;
            const u32x4 zz = (u32x4){0u, 0u, 0u, 0u};
            pq0 = zz; pq1 = zz; pk0 = zz; pk1 = zz; pz0 = zz; pz1 = zz;
            if (valid) { pq0 = *(const u32x4*)(Hb + go); pq1 = *(const u32x4*)(Hb + go + 8); pk0 = *(const u32x4*)(KN + go); pk1 = *(const u32x4*)(KN + go + 8);
                         pz0 = *(const u32x4*)(Z + go); pz1 = *(const u32x4*)(Z + go + 8); }
            const int col0 = 2048 + h * 128 + sub * 16;
#pragma unroll
            for (int j = 0; j < 4; ++j) {
                const int tt = c * 64 + i - 3 + j;
                pv[2 * j] = zz; pv[2 * j + 1] = zz;
                if (valid) {
                    if (tt >= 0) { const bf16_t* p = QKV + (row0 + tt) * 3072 + col0; pv[2 * j] = *(const u32x4*)p; pv[2 * j + 1] = *(const u32x4*)(p + 8); }
                    else if (samp) { const float* p = hist + (size_t)(3 + tt) * 3072 + col0; float x[16];
#pragma unroll
                        for (int e = 0; e < 16; e += 4) { const f32x4 v = *(const f32x4*)(p + e); x[e] = v.x; x[e + 1] = v.y; x[e + 2] = v.z; x[e + 3] = v.w; }
                        pv[2 * j] = pack8(x); pv[2 * j + 1] = pack8(x + 8); }
                }
            }
            pt = *(const u32x4*)(TB + (size_t)(ci0 + 8 * c) * 4096 + tid * 8);
            if (tid < 128) pg = GB[(size_t)(ci0 + 8 * c) * 128 + tid];
        };
        fetch(0);
        __syncthreads();
#pragma unroll 1
        for (int c = 0; c < nch; ++c) {
            {
                GDN_LANEVARS
                const int i = tid >> 3, sub = tid & 7;
                *(LAS u32x4*)(Qs + i * 136 + sub * 16) = pq0; *(LAS u32x4*)(Qs + i * 136 + sub * 16 + 8) = pq1;
                *(LAS u32x4*)(Ks + i * 136 + sub * 16) = pk0; *(LAS u32x4*)(Ks + i * 136 + sub * 16 + 8) = pk1;
                { const unsigned kw[8] = {pk0.x, pk0.y, pk0.z, pk0.w, pk1.x, pk1.y, pk1.z, pk1.w};
#pragma unroll
                  for (int e = 0; e < 8; ++e) { KTs[(sub * 16 + 2 * e) * 72 + i] = (bf16_t)(kw[e] & 0xFFFFu); KTs[(sub * 16 + 2 * e + 1) * 72 + i] = (bf16_t)(kw[e] >> 16); } }
                float y[16];
#pragma unroll
                for (int e = 0; e < 16; ++e) y[e] = 0.f;
#pragma unroll
                for (int j = 0; j < 4; ++j) { float x[16]; unpack8(pv[2 * j], x); unpack8(pv[2 * j + 1], x + 8);
#pragma unroll
                    for (int e = 0; e < 16; e += 4) { const f32x4 wv = *(const LAS f32x4*)(CW + j * 128 + sub * 16 + e); y[e] += wv.x * x[e]; y[e + 1] += wv.y * x[e + 1]; y[e + 2] += wv.z * x[e + 2]; y[e + 3] += wv.w * x[e + 3]; } }
                if (i < R) {
#pragma unroll
                    for (int e = 0; e < 16; ++e) y[e] = siluf(y[e]);
                } else {
#pragma unroll
                    for (int e = 0; e < 16; ++e) y[e] = 0.f;
                }
                *(LAS u32x4*)(Vs + i * 136 + sub * 16) = pack8(y); *(LAS u32x4*)(Vs + i * 136 + sub * 16 + 8) = pack8(y + 8);
                *(LAS u32x4*)(Ts + i * 72 + sub * 8) = pt;
                if (tid < 128) GC[tid] = pg;
                zc0 = pz0; zc1 = pz1;
            }
            __syncthreads();
            if (c + 1 < nch) fetch(c + 1);
            bf16x8 sfr[4];
            {
                GDN_LANEVARS
                bf16x8 qa[4]; ldfrag<4>(Qs + (w >> 1) * 16 * 136, 136, qa, lane);
#pragma unroll
                for (int t2 = 0; t2 < 2; ++t2) {
                    const int tl = w * 2 + t2, rb = tl >> 2, cb = tl & 3;
                    f32x4 acc = (f32x4){0.f, 0.f, 0.f, 0.f};
                    if (cb <= rb) acc = mm16a<4>(qa, Ks + cb * 16 * 136, 136, acc, lane);
                    const int j = cb * 16 + r; const float gj = GC[j];
#pragma unroll
                    for (int jj = 0; jj < 4; ++jj) { const int i = rb * 16 + quad * 4 + jj;
                        QKs[i * 72 + j] = f2bf((i >= j && cb <= rb) ? acc[jj] * __expf(GC[i] - gj) : 0.f); }
                }
                ldfrag<4>(STs + w * 16 * 136, 136, sfr, lane);
#pragma unroll
                for (int rt = 0; rt < 4; ++rt) {
                    f32x4 acc = (f32x4){0.f, 0.f, 0.f, 0.f};
                    acc = mm16b<4>(Ks + rt * 16 * 136, 136, sfr, acc, lane);
                    const int e = w * 16 + r; float p[4];
#pragma unroll
                    for (int jj = 0; jj < 4; ++jj) { const int j = rt * 16 + quad * 4 + jj; p[jj] = BETA[j] * (bf2f(Vs[j * 136 + e]) - __expf(GC[j]) * acc[jj]); }
                    u32x2 o; o.x = pk2(p[0], p[1]); o.y = pk2(p[2], p[3]);
                    *(LAS u32x2*)(PTs + e * 72 + rt * 16 + quad * 4) = o;
                }
            }
            __syncthreads();
            f32x4 o[4];
            {
                GDN_LANEVARS
                f32x4 u[4];
                { bf16x8 pfr[2]; ldfrag<2>(PTs + w * 16 * 72, 72, pfr, lane);
#pragma unroll
                for (int rt = 0; rt < 4; ++rt) u[rt] = mm16b<2>(Ts + rt * 16 * 72, 72, pfr, (f32x4){0.f, 0.f, 0.f, 0.f}, lane); }
                asm volatile("s_waitcnt lgkmcnt(0)" ::: "memory");
                const int e = w * 16 + r; const float gl = GC[63];
#pragma unroll
                for (int rt = 0; rt < 4; ++rt) {
                    const int i0 = rt * 16 + quad * 4;
                    u32x2 o1; o1.x = pk2(u[rt][0], u[rt][1]); o1.y = pk2(u[rt][2], u[rt][3]);
                    *(LAS u32x2*)(UTs + e * 72 + i0) = o1;
                    u32x2 o2; o2.x = pk2(u[rt][0] * __expf(gl - GC[i0]), u[rt][1] * __expf(gl - GC[i0 + 1])); o2.y = pk2(u[rt][2] * __expf(gl - GC[i0 + 2]), u[rt][3] * __expf(gl - GC[i0 + 3]));
                    *(LAS u32x2*)(UGs + e * 72 + i0) = o2;
                }
                asm volatile("s_waitcnt lgkmcnt(0)" ::: "memory");
                bf16x8 ufr[2]; ldfrag<2>(UTs + w * 16 * 72, 72, ufr, lane);
#pragma unroll
                for (int rt = 0; rt < 4; ++rt) {
                    const f32x4 a1 = mm16b<4>(Qs + rt * 16 * 136, 136, sfr, (f32x4){0.f, 0.f, 0.f, 0.f}, lane);
                    const f32x4 a2 = mm16b<2>(QKs + rt * 16 * 72, 72, ufr, (f32x4){0.f, 0.f, 0.f, 0.f}, lane);
#pragma unroll
                    for (int jj = 0; jj < 4; ++jj) o[rt][jj] = __expf(GC[rt * 16 + quad * 4 + jj]) * a1[jj] + a2[jj];
                }
                const float egl = __expf(gl);
                { bf16x8 gfr[2]; ldfrag<2>(UGs + w * 16 * 72, 72, gfr, lane);
#pragma unroll
                for (int dt = 0; dt < 8; ++dt) S[dt] = mm16b<2>(KTs + dt * 16 * 72, 72, gfr, S[dt] * egl, lane); }
                asm volatile("s_waitcnt lgkmcnt(0)" ::: "memory");
#pragma unroll
                for (int dt = 0; dt < 8; ++dt) { u32x2 ov; ov.x = pk2(S[dt][0], S[dt][1]); ov.y = pk2(S[dt][2], S[dt][3]); *(LAS u32x2*)(STs + (w * 16 + r) * 136 + dt * 16 + quad * 4) = ov; }
            }
            __syncthreads();
            { GDN_LANEVARS
#pragma unroll
            for (int rt = 0; rt < 4; ++rt)
#pragma unroll
                for (int jj = 0; jj < 4; ++jj) Os[(rt * 16 + quad * 4 + jj) * 129 + w * 16 + r] = o[rt][jj];
            }
            __syncthreads();
            {
                GDN_LANEVARS
                const int i = tid >> 3, sub = tid & 7, t = c * 64 + i;
                float v[16]; float ss = 0.f;
#pragma unroll
                for (int k = 0; k < 16; ++k) { v[k] = Os[i * 129 + sub * 16 + k]; ss += v[k] * v[k]; }
                ss += __shfl_xor(ss, 1); ss += __shfl_xor(ss, 2); ss += __shfl_xor(ss, 4);
                const float rn = rsqrtf(ss * (1.f / 128.f) + EPS);
                if (i < R) {
                    const size_t off = (row0 + t) * 1024 + h * 128 + sub * 16;
                    float z[16]; unpack8(zc0, z); unpack8(zc1, z + 8);
#pragma unroll
                    for (int k = 0; k < 16; ++k) v[k] = v[k] * rn * onorm[sub * 16 + k] * siluf(z[k]);
                    *(u32x4*)(Hb + off) = pack8(v); *(u32x4*)(Hb + off + 8) = pack8(v + 8);
                }
            }
            __syncthreads();
        }
        GDN_LANEVARS
        float* so = a.out + (samp ? O_GSS + ((size_t)(slot * 16 + b) * 8 + h) * 16384 : O_GSP + ((size_t)(slot * 32 + b) * 8 + h) * 16384);
#pragma unroll
        for (int dt = 0; dt < 8; ++dt)
#pragma unroll
            for (int jj = 0; jj < 4; ++jj) { so[(dt * 16 + quad * 4 + jj) * 128 + w * 16 + r] = S[dt][jj]; __builtin_amdgcn_sched_barrier(0); }
    }
}

__device__ __forceinline__ void mla_prep_phase(const Args& a) {
    const int lane = tidx() & 63, gw = bidx() * 8 + (tidx() >> 6), NGW = gridDim.x * 8;
    const bf16_t* PROJ = (const bf16_t*)(a.ws + BM_PROJ);
    bf16_t* CQ = (bf16_t*)(a.ws + BM_CQ); bf16_t* CKV = (bf16_t*)(a.ws + BM_CKV); bf16_t* KR = (bf16_t*)(a.ws + BM_KR);
    const f32x2* rope = (const f32x2*)(a.ws + WS_ROPE);
    float gq[6];
#pragma unroll
    for (int j = 0; j < 6; ++j) gq[j] = a.in[23][lane + 64 * j];
    const f32x4 gk = *(const f32x4*)(a.in[24] + 4 * lane);
#pragma unroll 1
    for (int row0 = gw * 4; row0 < MT; row0 += NGW * 4) {
        const bool samp = row0 >= NTP;
        bf16_t qh[4][6]; u32x2 kvh[4]; bf16_t x1h[4], x2h[4]; f32x2 cs[4];
#pragma unroll
        for (int rr = 0; rr < 4; ++rr) {
            const bf16_t* p = PROJ + (size_t)(row0 + rr) * 768;
#pragma unroll
            for (int j = 0; j < 6; ++j) qh[rr][j] = p[lane + 64 * j];
            kvh[rr] = *(const u32x2*)(p + 384 + 4 * lane);
            const int row = row0 + rr, pos = samp ? 1024 + ((row - NTP) & 31) : (row & 2047);
            x1h[rr] = p[640 + (lane & 15)]; x2h[rr] = p[656 + (lane & 15)]; cs[rr] = rope[pos * 16 + (lane & 15)];
        }
#pragma unroll
        for (int rr = 0; rr < 4; ++rr) {
            const int row = row0 + rr;
            const size_t krow = samp ? (size_t)NTP + (size_t)((row - NTP) >> 5) * 1056 + 1024 + ((row - NTP) & 31) : (size_t)row;
            float q[6]; float ss = 0.f;
#pragma unroll
            for (int j = 0; j < 6; ++j) { q[j] = bf2f(qh[rr][j]); ss += q[j] * q[j]; }
#pragma unroll
            for (int o = 1; o < 64; o <<= 1) ss += __shfl_xor(ss, o);
            float rn = rsqrtf(ss * (1.f / 384.f) + EPS);
#pragma unroll
            for (int j = 0; j < 6; ++j) CQ[(size_t)row * 384 + lane + 64 * j] = f2bf(q[j] * rn * gq[j]);
            const f32x4 kv = bf4(kvh[rr]);
            ss = kv.x * kv.x + kv.y * kv.y + kv.z * kv.z + kv.w * kv.w;
#pragma unroll
            for (int o = 1; o < 64; o <<= 1) ss += __shfl_xor(ss, o);
            rn = rsqrtf(ss * (1.f / 256.f) + EPS);
            const f32x4 kvn = kv * rn * gk;
            float* lo = samp ? a.out + O_MLS + (size_t)(row - NTP) * 256 : a.out + O_MLP + (size_t)row * 256;
            *(f32x4*)(lo + 4 * lane) = kvn;
            { u32x2 o; o.x = pk2(kvn.x, kvn.y); o.y = pk2(kvn.z, kvn.w); *(u32x2*)(CKV + krow * 256 + 4 * lane) = o; }
            if (lane < 16) {
                const float x1 = bf2f(x1h[rr]), x2 = bf2f(x2h[rr]);
                const float r1 = x1 * cs[rr].x - x2 * cs[rr].y, r2 = x1 * cs[rr].y + x2 * cs[rr].x;
                float* ko = samp ? a.out + O_MKS + (size_t)(row - NTP) * 32 : a.out + O_MKP + (size_t)row * 32;
                ko[lane] = r1; ko[lane + 16] = r2;
                KR[krow * 32 + lane] = f2bf(r1); KR[krow * 32 + 16 + lane] = f2bf(r2);
            }
        }
    }
    const size_t gt = (size_t)bidx() * NTHREADS + tidx(), NGT = (size_t)gridDim.x * NTHREADS;
    for (size_t i0 = gt; i0 < 16ull * 1024 * 64; i0 += 4 * NGT) {
        f32x4 v[4];
#pragma unroll
        for (int u = 0; u < 4; ++u) { const size_t i = i0 + u * NGT; if (i < 16ull * 1024 * 64) v[u] = *(const f32x4*)(a.in[6] + (i >> 6) * 256 + (int)(i & 63) * 4); }
#pragma unroll
        for (int u = 0; u < 4; ++u) { const size_t i = i0 + u * NGT; if (i < 16ull * 1024 * 64) {
            const size_t bk = i >> 6; const int c4 = (int)(i & 63) * 4; const size_t b = bk >> 10, kk = bk & 1023;
            u32x2 o; o.x = pk2(v[u].x, v[u].y); o.y = pk2(v[u].z, v[u].w);
            *(u32x2*)(CKV + ((size_t)NTP + b * 1056 + kk) * 256 + c4) = o; } }
    }
    for (size_t i = gt; i < 16ull * 1024 * 8; i += NGT) {
        const size_t bk = i >> 3; const int c4 = (int)(i & 7) * 4; const size_t b = bk >> 10, kk = bk & 1023;
        const f32x4 v = *(const f32x4*)(a.in[7] + bk * 32 + c4);
        u32x2 o; o.x = pk2(v.x, v.y); o.y = pk2(v.z, v.w);
        *(u32x2*)(KR + ((size_t)NTP + b * 1056 + kk) * 32 + c4) = o;
    }
}

template <bool MLA>
__device__ __forceinline__ void attn_phase(const Args& a, LAS unsigned char* lds) {
    constexpr int DQ = MLA ? 96 : 64, QST = DQ + 8, NKS = DQ / 32;
    LAS bf16_t* Qs = (LAS bf16_t*)lds;
    LAS bf16_t* KsB = Qs + 256 * QST;
    constexpr int KVB = 64 * QST + 64 * 68;
    const int tid = tidx(), lane = tid & 63, w = __builtin_amdgcn_readfirstlane(tid >> 6), r = lane & 15, quad = lane >> 4;
    bf16_t* Ob = (bf16_t*)(a.ws + WS_H);
    const bf16_t* Qg = (const bf16_t*)(a.ws + (MLA ? BM_Q : BS_PROJ));
    const bf16_t* KVg = (const bf16_t*)(a.ws + BM_KV); const bf16_t* KRg = (const bf16_t*)(a.ws + BM_KR);
    const bf16_t* SP = (const bf16_t*)(a.ws + BS_PROJ);
    const bf16_t* KC = (const bf16_t*)(a.ws + WS_SWAKC); const bf16_t* VC = (const bf16_t*)(a.ws + WS_SWAVC);
    const f32x2* rope = (const f32x2*)(a.ws + WS_ROPE);
    const float* biasT = (const float*)(a.ws + WS_BIAS);
    const int NP = 4096, NITEM = NP + (MLA ? 256 : 64);
    const float scale = (MLA ? 0.10206207261596575f : 0.125f) * 1.4426950408889634f;

#pragma unroll 1
    for (int item = bidx(); item < NITEM; item += gridDim.x) {
        const bool samp = item >= NP;
        int b, h = 0, kvh = 0, cch = 0, p4 = 0;
        size_t qrow0, krow0 = 0; int kt0 = 0, kt1, nq;
        if (MLA) {
            if (!samp) {
                int bh;
                if (gridDim.x == 256) {
                    const int c = item & 255, n = item >> 8, xcd = c & 7, sl = c >> 3;
                    bh = n * 32 + xcd * 4 + (sl >> 3); p4 = ((sl & 7) + n) & 7;
                } else { p4 = 7 - (item >> 9); bh = item & 511; }
                b = bh >> 4; h = bh & 15; qrow0 = (size_t)b * 2048 + p4 * 256; krow0 = (size_t)b * 2048; kt1 = 4 * p4 + 4; nq = 256; }
            else { const int it = item - NP; b = it >> 4; h = it & 15; qrow0 = (size_t)NTP + b * 32; krow0 = (size_t)NTP + (size_t)b * 1056; kt1 = 17; nq = 32; }
        } else {
            if (!samp) { b = item >> 7; cch = (item >> 2) & 31; kvh = item & 3; qrow0 = (size_t)b * 2048 + cch * 64; kt0 = cch >= 2 ? 0 : 2 - cch; kt1 = 3; nq = 256; }
            else { const int it = item - NP; b = it >> 2; kvh = it & 3; qrow0 = (size_t)NTP + b * 32; kt1 = 3; nq = 128; }
        }
        int head, nkw, qi[2]; bool qvalid[2];
        if (MLA) { head = h; nkw = samp ? 1056 : (4 * p4 + (w >> 1) + 1) * 64;
#pragma unroll
            for (int g = 0; g < 2; ++g) { qi[g] = w * 32 + g * 16 + r; qvalid[g] = qi[g] < nq; } }
        else if (!samp) { head = kvh * 4 + (w >> 1); nkw = 192;
#pragma unroll
            for (int g = 0; g < 2; ++g) { qi[g] = (w & 1) * 32 + g * 16 + r; qvalid[g] = true; } }
        else { head = kvh * 4 + (w & 3); nkw = 160;
#pragma unroll
            for (int g = 0; g < 2; ++g) { qi[g] = g * 16 + r; qvalid[g] = w < 4; } }

        __syncthreads();
        if (MLA) {
            for (int idx = tid; idx < 256 * 8; idx += NTHREADS) { const int lr = idx >> 3, ch = idx & 7; const int rr = lr < nq ? lr : 0;
                *(LAS u32x4*)(Qs + lr * QST + ch * 8) = *(const u32x4*)(Qg + (qrow0 + rr) * 1536 + h * 96 + ch * 8); }
            { const int lr = tid >> 1, ch = tid & 1; const int rr = lr < nq ? lr : 0;
                const bf16_t* src = Qg + (qrow0 + rr) * 1536 + h * 96 + 64 + ch * 8;
                float x1[8], x2[8], o1[8], o2[8]; unpack8(*(const u32x4*)src, x1); unpack8(*(const u32x4*)(src + 16), x2);
                const int pos = (samp ? 1024 : p4 * 256) + rr;
                const f32x2* cs = rope + pos * 16 + ch * 8;
#pragma unroll
                for (int k = 0; k < 8; ++k) { const f32x2 c = cs[k]; o1[k] = x1[k] * c.x - x2[k] * c.y; o2[k] = x1[k] * c.y + x2[k] * c.x; }
                *(LAS u32x4*)(Qs + lr * QST + 64 + ch * 8) = pack8(o1); *(LAS u32x4*)(Qs + lr * QST + 80 + ch * 8) = pack8(o2); }
        } else {
            for (int idx = tid; idx < 256 * 8; idx += NTHREADS) { const int lr = idx >> 3, ch = idx & 7;
                int hd, qq;
                if (!samp) { hd = kvh * 4 + (lr >> 6); qq = lr & 63; } else if (lr < 128) { hd = kvh * 4 + (lr >> 5); qq = lr & 31; } else { hd = kvh * 4; qq = 0; }
                *(LAS u32x4*)(Qs + lr * QST + ch * 8) = *(const u32x4*)(Qg + (qrow0 + qq) * 1536 + hd * 64 + ch * 8); }
        }
        float m[2], lsum[2];
        f32x4 O[2][4];
#pragma unroll
        for (int g = 0; g < 2; ++g) {
            if (MLA) { m[g] = -1e30f; lsum[g] = 0.f; } else { m[g] = a.in[29][head] * 1.4426950408889634f; lsum[g] = quad == 0 ? 1.f : 0.f; }
#pragma unroll
            for (int et = 0; et < 4; ++et) O[g][et] = (f32x4){0.f, 0.f, 0.f, 0.f};
        }
        bf16x8 qf[2][NKS];
        u32x4 pk0 = (u32x4){0u, 0u, 0u, 0u}, pk1 = pk0, pv = pk0;
        auto fetch = [&](int kt) {
            pk0 = (u32x4){0u, 0u, 0u, 0u}; pk1 = pk0; pv = pk0;
            if (MLA) {
                { const int j = tid / 12, ch = tid % 12; const int kk = kt * 64 + j; const size_t kr = krow0 + kk;
                  if (!samp || kk < 1056) pk0 = ch < 8 ? *(const u32x4*)(KVg + kr * 2048 + h * 128 + ch * 8) : *(const u32x4*)(KRg + kr * 32 + (ch - 8) * 8); }
                if (tid < 256) { const int idx = tid + 512; const int j = idx / 12, ch = idx % 12; const int kk = kt * 64 + j; const size_t kr = krow0 + kk;
                  if (!samp || kk < 1056) pk1 = ch < 8 ? *(const u32x4*)(KVg + kr * 2048 + h * 128 + ch * 8) : *(const u32x4*)(KRg + kr * 32 + (ch - 8) * 8); }
                { const int j = tid >> 3, ec = tid & 7; const int kk = kt * 64 + j; const size_t kr = krow0 + kk;
                  if (!samp || kk < 1056) pv = *(const u32x4*)(KVg + kr * 2048 + h * 128 + 64 + ec * 8); }
            } else {
                const int j = tid >> 3, ch = tid & 7; const int kk = kt * 64 + j;
                if (!samp) { const size_t kr = (size_t)b * 2048 + (size_t)(cch - 2 + kt) * 64 + j;
                    pk0 = *(const u32x4*)(SP + kr * 1536 + 1024 + kvh * 64 + ch * 8); pv = *(const u32x4*)(SP + kr * 1536 + 1280 + kvh * 64 + ch * 8); }
                else if (kk < 128) { pk0 = *(const u32x4*)(KC + ((size_t)b * 128 + kk) * 256 + kvh * 64 + ch * 8); pv = *(const u32x4*)(VC + ((size_t)b * 128 + kk) * 256 + kvh * 64 + ch * 8); }
                else if (kk < 160) { const size_t kr = (size_t)NTP + b * 32 + (kk - 128);
                    pk0 = *(const u32x4*)(SP + kr * 1536 + 1024 + kvh * 64 + ch * 8); pv = *(const u32x4*)(SP + kr * 1536 + 1280 + kvh * 64 + ch * 8); }
            }
        };
        auto stash = [&](int par) {
            LAS bf16_t* Ks = KsB + par * KVB; LAS bf16_t* VTs = Ks + 64 * QST;
            if (MLA) {
                { const int j = tid / 12, ch = tid % 12; *(LAS u32x4*)(Ks + j * QST + ch * 8) = pk0; }
                if (tid < 256) { const int idx = tid + 512; const int j = idx / 12, ch = idx % 12; *(LAS u32x4*)(Ks + j * QST + ch * 8) = pk1; }
            } else { const int j = tid >> 3, ch = tid & 7; *(LAS u32x4*)(Ks + j * QST + ch * 8) = pk0; }
            { const int j = tid >> 3, ec = tid & 7; const unsigned vv[4] = {pv.x, pv.y, pv.z, pv.w};
#pragma unroll
              for (int k = 0; k < 4; ++k) { VTs[(ec * 8 + 2 * k) * 68 + j] = (bf16_t)(vv[k] & 0xFFFFu); VTs[(ec * 8 + 2 * k + 1) * 68 + j] = (bf16_t)(vv[k] >> 16); } }
        };
        fetch(kt0);
        stash(0);
        if (kt0 + 1 < kt1) fetch(kt0 + 1);
#pragma unroll 1
        for (int kt = kt0; kt < kt1; ++kt) {
            __syncthreads();
            if (kt + 1 < kt1) { stash((kt + 1 - kt0) & 1); if (kt + 2 < kt1) fetch(kt + 2); }
            const LAS bf16_t* Ks = KsB + ((kt - kt0) & 1) * KVB; const LAS bf16_t* VTs = Ks + 64 * QST;
            if (kt == kt0) {
#pragma unroll
                for (int g = 0; g < 2; ++g)
#pragma unroll
                    for (int ks = 0; ks < NKS; ++ks) qf[g][ks] = *(const LAS bf16x8*)(Qs + (w * 32 + g * 16 + r) * QST + ks * 32 + quad * 8);
            }
            if (kt * 64 >= nkw) continue;
            f32x4 s[2][4];
#pragma unroll
            for (int sub = 0; sub < 4; ++sub) {
                f32x4 a0 = (f32x4){0.f, 0.f, 0.f, 0.f}, a1 = a0;
#pragma unroll
                for (int ks = 0; ks < NKS; ++ks) {
                    const bf16x8 kf = *(const LAS bf16x8*)(Ks + (sub * 16 + r) * QST + ks * 32 + quad * 8);
                    a0 = __builtin_amdgcn_mfma_f32_16x16x32_bf16(kf, qf[0][ks], a0, 0, 0, 0);
                    a1 = __builtin_amdgcn_mfma_f32_16x16x32_bf16(kf, qf[1][ks], a1, 0, 0, 0);
                }
                s[0][sub] = a0; s[1][sub] = a1;
            }
            bf16x8 pf[2][2];
#pragma unroll
            for (int g = 0; g < 2; ++g) {
                float mx = -INFINITY;
#pragma unroll
                for (int sub = 0; sub < 4; ++sub)
#pragma unroll
                    for (int jj = 0; jj < 4; ++jj) {
                        const int kk = kt * 64 + sub * 16 + quad * 4 + jj;
                        float v = s[g][sub][jj] * scale;
                        if (!MLA) v += biasT[head * 256 + 191 + qi[g] - kk];
                        if (kk >= nkw) v = -INFINITY;
                        s[g][sub][jj] = v; mx = fmaxf(mx, v);
                    }
                mx = fmaxf(mx, __shfl_xor(mx, 16)); mx = fmaxf(mx, __shfl_xor(mx, 32));
                const float mn = fmaxf(m[g], mx), alpha = __builtin_amdgcn_exp2f(m[g] - mn); m[g] = mn;
                float ps = 0.f;
#pragma unroll
                for (int sub = 0; sub < 4; ++sub)
#pragma unroll
                    for (int jj = 0; jj < 4; ++jj) { const float pv_ = __builtin_amdgcn_exp2f(s[g][sub][jj] - mn); s[g][sub][jj] = pv_; ps += pv_; }
                lsum[g] = lsum[g] * alpha + ps;
#pragma unroll
                for (int et = 0; et < 4; ++et) O[g][et] *= alpha;
#pragma unroll
                for (int s2 = 0; s2 < 2; ++s2) {
                    const unsigned a0 = pk2(s[g][2 * s2][0], s[g][2 * s2][1]), a1 = pk2(s[g][2 * s2][2], s[g][2 * s2][3]), a2 = pk2(s[g][2 * s2 + 1][0], s[g][2 * s2 + 1][1]), a3 = pk2(s[g][2 * s2 + 1][2], s[g][2 * s2 + 1][3]);
                    const u32x4 pu = (u32x4){a0, a1, a2, a3}; pf[g][s2] = *(const bf16x8*)&pu;
                }
            }
#pragma unroll
            for (int s2 = 0; s2 < 2; ++s2)
#pragma unroll
                for (int et = 0; et < 4; ++et) {
                    const LAS bf16_t* vp = VTs + (et * 16 + r) * 68 + s2 * 32 + quad * 4;
                    const u32x2 v0 = *(const LAS u32x2*)vp, v1 = *(const LAS u32x2*)(vp + 16);
                    const u32x4 vu = (u32x4){v0.x, v0.y, v1.x, v1.y};
                    O[0][et] = __builtin_amdgcn_mfma_f32_16x16x32_bf16(*(const bf16x8*)&vu, pf[0][s2], O[0][et], 0, 0, 0);
                    O[1][et] = __builtin_amdgcn_mfma_f32_16x16x32_bf16(*(const bf16x8*)&vu, pf[1][s2], O[1][et], 0, 0, 0);
                }
        }
#pragma unroll
        for (int g = 0; g < 2; ++g) {
            float l = lsum[g]; l += __shfl_xor(l, 16); l += __shfl_xor(l, 32);
            const float inv = 1.f / l;
            if (qvalid[g]) {
                bf16_t* op = Ob + (qrow0 + qi[g]) * 1024 + head * 64 + quad * 4;
#pragma unroll
                for (int et = 0; et < 4; ++et) { u32x2 o; o.x = pk2(O[g][et][0] * inv, O[g][et][1] * inv); o.y = pk2(O[g][et][2] * inv, O[g][et][3] * inv); *(u32x2*)(op + et * 16) = o; }
            }
        }
    }
}

__device__ __forceinline__ void swa_state_out(const Args& a) {
    const bf16_t* SP = (const bf16_t*)(a.ws + BS_PROJ);
    const size_t gt = (size_t)bidx() * NTHREADS + tidx(), NGT = (size_t)gridDim.x * NTHREADS;
    for (size_t i = gt; i < 32ull * 128 * 64; i += NGT) { const size_t b = i >> 13, j = (i >> 6) & 127; const int c = (int)(i & 63) * 4;
        const size_t row = b * 2048 + 1920 + j;
        const u32x2 k = *(const u32x2*)(SP + row * 1536 + 1024 + c), v = *(const u32x2*)(SP + row * 1536 + 1280 + c);
        *(f32x4*)(a.out + O_SKP + i * 4) = bf4(k); *(f32x4*)(a.out + O_SVP + i * 4) = bf4(v); }
    for (size_t i = gt; i < 16ull * 128 * 64; i += NGT) { const size_t b = i >> 13, j = (i >> 6) & 127; const int c = (int)(i & 63) * 4;
        if (j < 96) { *(f32x4*)(a.out + O_SKS + i * 4) = *(const f32x4*)(a.in[8] + (b * 128 + 32 + j) * 256 + c); *(f32x4*)(a.out + O_SVS + i * 4) = *(const f32x4*)(a.in[9] + (b * 128 + 32 + j) * 256 + c); }
        else { const size_t row = (size_t)NTP + b * 32 + (j - 96);
            *(f32x4*)(a.out + O_SKS + i * 4) = bf4(*(const u32x2*)(SP + row * 1536 + 1024 + c)); *(f32x4*)(a.out + O_SVS + i * 4) = bf4(*(const u32x2*)(SP + row * 1536 + 1280 + c)); } }
}

__device__ __forceinline__ void ffn_fix_phase(const Args& a, int layer) {
    bf16_t* U = (bf16_t*)(a.ws + BF_U); const float* GD = (const float*)(a.ws + BF_GD); const float* UD = (const float*)(a.ws + BF_UD);
    const float* cw = a.in[33] + (size_t)layer * 3 * DFF; const float* cb = a.in[34] + (size_t)layer * DFF;
    const size_t gt = (size_t)bidx() * NTHREADS + tidx(), NGT = (size_t)gridDim.x * NTHREADS;
    constexpr int CPR = DFF / 8, NG = MT / 32;
    auto fix_item = [&](size_t i, size_t& uoff) -> u32x4 {
        const int grp = (int)(i / (2 * CPR)), s = (int)((i / CPR) & 1), c0 = (int)(i % CPR) * 8;
        const int row = grp * 32 + s; const bool samp = row >= NTP; const bool first = samp || (grp & 63) == 0;
        const float* hp = a.in[10] + (size_t)(layer * 16 + (samp ? grp - NTP / 32 : 0)) * 2 * DFF + c0;
        const float* gc = GD + ((size_t)grp * 4 + 2 + s) * DFF + c0;
        const float* g1p = s == 1 ? GD + ((size_t)grp * 4 + 2) * DFF + c0 : (first ? hp + DFF : GD + ((size_t)(grp - 1) * 4 + 1) * DFF + c0);
        const float* g2p = s == 1 ? (first ? hp + DFF : GD + ((size_t)(grp - 1) * 4 + 1) * DFF + c0) : (first ? hp : GD + ((size_t)(grp - 1) * 4 + 0) * DFF + c0);
        const bool z1 = (s == 0) && first && !samp, z2 = first && !samp;
        const float* up = UD + ((size_t)grp * 2 + s) * DFF + c0;
        float o[8];
#pragma unroll
        for (int k = 0; k < 8; ++k) { const float g1 = z1 ? 0.f : g1p[k], g2 = z2 ? 0.f : g2p[k];
            const float y = cw[c0 + k] * g2 + cw[DFF + c0 + k] * g1 + cw[2 * DFF + c0 + k] * gc[k] + cb[c0 + k]; o[k] = siluf(y) * up[k]; }
        uoff = (size_t)row * DFF + c0;
        return pack8(o);
    };
    const size_t NIT = (size_t)NG * 2 * CPR;
    for (size_t i0 = gt; i0 < NIT; i0 += 2 * NGT) {
        const size_t i1 = i0 + NGT; size_t u0 = 0, u1 = 0;
        const u32x4 r0 = fix_item(i0, u0);
        u32x4 r1 = (u32x4){0u, 0u, 0u, 0u};
        if (i1 < NIT) r1 = fix_item(i1, u1);
        *(u32x4*)(U + u0) = r0;
        if (i1 < NIT) *(u32x4*)(U + u1) = r1;
    }
    for (size_t i = gt; i < 48ull * 2 * DFF; i += NGT) { const int sq = (int)(i / (2 * DFF)), j = (int)((i / DFF) & 1), c = (int)(i % DFF);
        const int grp = sq < 32 ? sq * 64 + 63 : NTP / 32 + (sq - 32);
        const float v = GD[((size_t)grp * 4 + j) * DFF + c];
        if (sq < 32) a.out[O_FCP + ((size_t)(layer * 32 + sq) * 2 + j) * DFF + c] = v; else a.out[O_FCS + ((size_t)(layer * 16 + sq - 32) * 2 + j) * DFF + c] = v; }
}

#define XB_TMO      128
#define XB_XCNT(j)  (256  + 64 * (j))
#define XB_XSUB(j)  (1280 + 64 * (j))
#define XB_XGEN(j)  (2304 + 64 * (j))
#define XB_TOP      3328
#define XB_TOPGEN   3392
#define XCD_BAR_WORDS 3456
#define XB_SPIN_CAP (1u << 18)
__device__ __forceinline__ unsigned xb_ld(unsigned* p)              { return __hip_atomic_load(p, __ATOMIC_RELAXED, __HIP_MEMORY_SCOPE_AGENT); }
__device__ __forceinline__ unsigned xb_add(unsigned* p, unsigned v) { return __hip_atomic_fetch_add(p, v, __ATOMIC_RELAXED, __HIP_MEMORY_SCOPE_AGENT); }
__device__ __forceinline__ unsigned xb_xcc_id() { return (unsigned)__builtin_amdgcn_s_getreg((3 << 11) | 20) & 0xFu; }
#define XB_SPIN(cond, bar) do { unsigned _sp = 0; while (cond) { __builtin_amdgcn_s_sleep(1); \
    if ((++_sp & 255u) == 0u) { if (xb_ld(&(bar)[XB_TMO])) break; if (_sp > XB_SPIN_CAP) { atomicAdd(&(bar)[XB_TMO], 1u); break; } } } } while (0)
struct XcdBarrier { unsigned* bar; unsigned x; volatile LAS unsigned* st; };
__device__ __forceinline__ XcdBarrier xcd_barrier_post(unsigned* bar, volatile LAS unsigned* st) {
    XcdBarrier b; b.bar = bar; b.x = xb_xcc_id(); b.st = st;
    if (threadIdx.x == 0) (void)xb_add(&bar[XB_XCNT(b.x)], 1u);
    return b;
}
__device__ __forceinline__ void xcd_barrier_complete(unsigned* bar, unsigned x, unsigned& nloc, unsigned& nx) {
    const unsigned G = gridDim.x * gridDim.y * gridDim.z;
    unsigned sum, cnt, mine, sp = 0u;
    for (;;) {
        sum = 0u; cnt = 0u; mine = 0u;
#pragma unroll
        for (unsigned j = 0; j < 16; ++j) { const unsigned c = xb_ld(&bar[XB_XCNT(j)]); sum += c; cnt += (c > 0u) ? 1u : 0u; mine = (j == x) ? c : mine; }
        if (sum == G) break;
        __builtin_amdgcn_s_sleep(1);
        if ((++sp & 255u) == 0u) { if (xb_ld(&bar[XB_TMO])) break; if (sp > XB_SPIN_CAP) { atomicAdd(&bar[XB_TMO], 1u); break; } }
    }
    nloc = mine > 0u ? mine : 1u; nx = cnt > 0u ? cnt : 1u;
}
__device__ __forceinline__ void xcd_barrier(const XcdBarrier& b) {
    asm volatile("s_waitcnt vmcnt(0)" ::: "memory");
    __syncthreads();
    if (threadIdx.x == 0) {
        unsigned* bar = b.bar;
        __builtin_amdgcn_s_waitcnt(0);
        unsigned nloc = b.st[0], nx = b.st[1];
        if (nloc == 0u) { xcd_barrier_complete(bar, b.x, nloc, nx); b.st[0] = nloc; b.st[1] = nx; }
        const unsigned old = xb_add(&bar[XB_XSUB(b.x)], 1u);
        const unsigned gen = old / nloc;
        if (old + 1u == (gen + 1u) * nloc) {
            __builtin_amdgcn_fence(__ATOMIC_RELEASE, "agent");
            asm volatile("s_waitcnt vmcnt(0)" ::: "memory");
            const unsigned og = xb_add(&bar[XB_TOP], 1u);
            const unsigned tg = og / nx;
            if (og + 1u == (tg + 1u) * nx) xb_add(&bar[XB_TOPGEN], 1u);
            else XB_SPIN(xb_ld(&bar[XB_TOPGEN]) == tg, bar);
            __builtin_amdgcn_fence(__ATOMIC_ACQUIRE, "agent");
            xb_add(&bar[XB_XGEN(b.x)], 1u);
            asm volatile("s_waitcnt vmcnt(0)" ::: "memory");
        } else {
            XB_SPIN(xb_ld(&bar[XB_XGEN(b.x)]) == gen, bar);
            __builtin_amdgcn_fence(__ATOMIC_ACQUIRE, "agent");
            asm volatile("s_waitcnt vmcnt(0)" ::: "memory");
        }
    }
    __syncthreads();
}

__global__ void __launch_bounds__(NTHREADS, 2) fwd_megakernel(Args a) {
    extern __shared__ __attribute__((aligned(16))) unsigned char smem[];
    LAS unsigned char* lds = (LAS unsigned char*)smem;
    cg::grid_group grid = cg::this_grid();
    bf16_t* WT = (bf16_t*)(a.ws + WS_WT);
    bf16_t* H = (bf16_t*)(a.ws + WS_H);
    const float* MOD = (const float*)(a.ws + WS_MOD);

    volatile LAS unsigned* xst = (volatile LAS unsigned*)(lds + XST_OFF);
    if (threadIdx.x == 0) { xst[0] = 0u; xst[1] = 0u; xst[2] = 0u; xst[3] = 0u; }
    __syncthreads();
    const XcdBarrier xb = xcd_barrier_post((unsigned*)(a.ws + WS_BAR), xst);
    prep_phase(a, lds);
    grid.sync();

#pragma unroll 1
    for (int layer = 0; layer < 4; ++layer) {
        const int kind = layer % 3, slot = layer / 3;
        const float* modl = MOD + (size_t)layer * 48 * 6144;
        norm_phase(a, layer == 0, a.in[13] + layer * 1024, layer, 0);
        xcd_barrier(xb);
        Epi res{}; res.mode = 0; res.X = a.out; res.srcP = layer == 0 ? a.in[0] : nullptr; res.srcS = layer == 0 ? a.in[1] : nullptr; res.gate = modl + 2 * 1024;
        if (kind == 0) {
            Epi e{}; e.mode = 1; e.o0 = (bf16_t*)(a.ws + BG_QKV); e.ld0 = 3072; e.t1 = 12; e.o1 = (bf16_t*)(a.ws + BG_Z); e.ld1 = 1024; e.t2 = 16; e.o2 = (float*)(a.ws + BG_AB);
            gemm_phase(lds, H, WT + WT_GIN + (size_t)slot * 4352 * 1024, MT, 4352, 1024, e);
            xcd_barrier(xb);
            gdn_pre_phase(a, lds, slot);
            xcd_barrier(xb);
            gdn_phase(a, lds, slot);
            xcd_barrier(xb);
            gemm_phase(lds, H, WT + WT_GO + (size_t)slot * 1024 * 1024, MT, 1024, 1024, res);
        } else if (kind == 1) {
            Epi e{}; e.mode = 1; e.o0 = (bf16_t*)(a.ws + BM_PROJ); e.ld0 = 768; e.t1 = 3; e.t2 = 3;
            gemm_phase(lds, H, WT + WT_MIN, MT, 768, 1024, e);
            xcd_barrier(xb);
            mla_prep_phase(a);
            xcd_barrier(xb);
            Epi eq{}; eq.mode = 1; eq.o0 = (bf16_t*)(a.ws + BM_Q); eq.ld0 = 1536; eq.t1 = 6; eq.t2 = 6;
            gemm_phase(lds, (const bf16_t*)(a.ws + BM_CQ), WT + WT_QUP, MT, 1536, 384, eq);
            Epi ek{}; ek.mode = 1; ek.o0 = (bf16_t*)(a.ws + BM_KV); ek.ld0 = 2048; ek.t1 = 8; ek.t2 = 8;
            gemm_phase(lds, (const bf16_t*)(a.ws + BM_CKV), WT + WT_KVUP, MK, 2048, 256, ek);
            xcd_barrier(xb);
            attn_phase<true>(a, lds);
            xcd_barrier(xb);
            gemm_phase(lds, H, WT + WT_MO, MT, 1024, 1024, res);
        } else {
            Epi e{}; e.mode = 1; e.o0 = (bf16_t*)(a.ws + BS_PROJ); e.ld0 = 1536; e.t1 = 6; e.t2 = 6;
            gemm_phase(lds, H, WT + WT_SIN, MT, 1536, 1024, e);
            xcd_barrier(xb);
            swa_state_out(a);
            attn_phase<false>(a, lds);
            xcd_barrier(xb);
            gemm_phase(lds, H, WT + WT_SO, MT, 1024, 1024, res);
        }
        xcd_barrier(xb);
        norm_phase(a, false, a.in[14] + layer * 1024, layer, 3);
        xcd_barrier(xb);
        {
            Epi e{}; e.mode = 2; e.o0 = (bf16_t*)(a.ws + BF_U); e.o2 = (float*)(a.ws + BF_GD); e.ud = (float*)(a.ws + BF_UD);
            e.cw = a.in[33] + (size_t)layer * 3 * DFF; e.cb = a.in[34] + (size_t)layer * DFF; e.cwl = (const LAS bf16_t*)(lds + CWL_OFF);
            gemm_phase(lds, H, WT + WT_FIN + (size_t)layer * 5632 * 1024, MT, 5632, 1024, e);
        }
        xcd_barrier(xb);
        ffn_fix_phase(a, layer);
        xcd_barrier(xb);
        {
            Epi r2{}; r2.mode = 0; r2.X = a.out; r2.srcP = nullptr; r2.srcS = nullptr; r2.gate = modl + 5 * 1024;
            gemm_phase(lds, (const bf16_t*)(a.ws + BF_U), WT + WT_FOUT + (size_t)layer * 1024 * 2816, MT, 1024, 2816, r2);
        }
        xcd_barrier(xb);
    }
    final_norm_phase(a);
}

extern "C" void kernel_launch(void* const* d_in, const int* in_sizes, int n_in, void* d_out, int out_size, void* d_ws, size_t ws_size, hipStream_t stream) {
    static int grid = 0;
    if (grid == 0) {
        if (n_in != 36 || (size_t)out_size != O_END || ws_size < WS_NEED) {
            fprintf(stderr, "kernel_launch: unexpected shapes: n_in %d out %d (want %zu) ws %zu (need %zu)\n", n_in, out_size, (size_t)O_END, ws_size, (size_t)WS_NEED);
            grid = -1; return; }
        int dev = 0, cus = 0, per_cu = 0;
        hipGetDevice(&dev);
        hipDeviceGetAttribute(&cus, hipDeviceAttributeMultiprocessorCount, dev);
        if (hipFuncSetAttribute((const void*)fwd_megakernel, hipFuncAttributeMaxDynamicSharedMemorySize, LDS_BYTES) != hipSuccess) { fprintf(stderr, "kernel_launch: hipFuncSetAttribute failed\n"); grid = -1; return; }
        if (hipOccupancyMaxActiveBlocksPerMultiprocessor(&per_cu, (const void*)fwd_megakernel, NTHREADS, LDS_BYTES) != hipSuccess || per_cu < 1) {
            fprintf(stderr, "kernel_launch: occupancy query gives %d blocks per CU\n", per_cu); (void)hipGetLastError(); per_cu = 1; }
        grid = cus;
    }
    if (grid < 0) return;
    Args a{};
    for (int i = 0; i < 36; ++i) a.in[i] = (const float*)d_in[i];
    a.out = (float*)d_out; a.ws = (unsigned char*)d_ws;
    if (hipMemsetAsync((char*)d_ws + WS_BAR, 0, XCD_BAR_WORDS * 4, stream) != hipSuccess) { fprintf(stderr, "kernel_launch: memset of the barrier words failed\n"); return; }
    void* args[] = {&a};
    hipError_t e = hipLaunchCooperativeKernel((const void*)fwd_megakernel, dim3(grid), dim3(NTHREADS), args, LDS_BYTES, stream);
    if (e != hipSuccess) fprintf(stderr, "kernel_launch: cooperative launch failed: %s (grid %d)\n", hipGetErrorString(e), grid);
}
```

```cpp
#include <hip/hip_runtime.h>
#include <hip/hip_cooperative_groups.h>
#include <cstdio>
#include <cstdint>
namespace cg = cooperative_groups;

#define LAS __attribute__((address_space(3)))
#define OPAQUE_V(x) asm volatile("" : "+v"(x))
#define OPAQUE_S(x) asm volatile("" : "+s"(x))
__device__ __forceinline__ int tidx() { int t = threadIdx.x; OPAQUE_V(t); return t; }
__device__ __forceinline__ int bidx() { int b = blockIdx.x; OPAQUE_S(b); return b; }
typedef unsigned short bf16_t;
typedef short bf16x8 __attribute__((ext_vector_type(8)));
typedef short bf16x4 __attribute__((ext_vector_type(4)));
typedef float f32x4 __attribute__((ext_vector_type(4)));
typedef float f32x2 __attribute__((ext_vector_type(2)));
typedef unsigned u32x4 __attribute__((ext_vector_type(4)));
typedef unsigned u32x2 __attribute__((ext_vector_type(2)));

constexpr int D = 1024, NTP = 65536, NTS = 512, MT = NTP + NTS, NSEQ = 48;
constexpr int MK = NTP + 16 * 1056;
constexpr int DFF = 2816;
constexpr int XS = 2048;
constexpr float EPS = 1e-6f;
constexpr int NTHREADS = 512;
constexpr int LDS_BYTES = 163840;
constexpr int XST_OFF = LDS_BYTES - 16, CWL_OFF = 131072;

constexpr size_t O_Y = 0;
constexpr size_t O_YS = O_Y + (size_t)NTP * D;
constexpr size_t O_GCP = O_YS + (size_t)NTS * D;
constexpr size_t O_GCS = O_GCP + 2ull * 32 * 3 * 3072;
constexpr size_t O_GSP = O_GCS + 2ull * 16 * 3 * 3072;
constexpr size_t O_GSS = O_GSP + 2ull * 32 * 8 * 16384;
constexpr size_t O_MLP = O_GSS + 2ull * 16 * 8 * 16384;
constexpr size_t O_MLS = O_MLP + 32ull * 2048 * 256;
constexpr size_t O_MKP = O_MLS + 16ull * 32 * 256;
constexpr size_t O_MKS = O_MKP + 32ull * 2048 * 32;
constexpr size_t O_SKP = O_MKS + 16ull * 32 * 32;
constexpr size_t O_SKS = O_SKP + 32ull * 128 * 256;
constexpr size_t O_SVP = O_SKS + 16ull * 128 * 256;
constexpr size_t O_SVS = O_SVP + 32ull * 128 * 256;
constexpr size_t O_FCP = O_SVS + 16ull * 128 * 256;
constexpr size_t O_FCS = O_FCP + 4ull * 32 * 2 * DFF;
constexpr size_t O_END = O_FCS + 4ull * 16 * 2 * DFF;

constexpr size_t al256(size_t x) { return (x + 255) & ~(size_t)255; }
constexpr size_t WS_BAR = 0;
constexpr size_t WS_MOD = 16384;
constexpr size_t WS_ROPE = al256(WS_MOD + 4ull * 48 * 6144 * 4);
constexpr size_t WS_BIAS = al256(WS_ROPE + 2048ull * 16 * 8);
constexpr size_t WS_SWAKC = al256(WS_BIAS + 16ull * 256 * 4);
constexpr size_t WS_SWAVC = al256(WS_SWAKC + 16ull * 128 * 256 * 2);
constexpr size_t WS_WT = al256(WS_SWAVC + 16ull * 128 * 256 * 2);
constexpr size_t WT_GIN = 0;
constexpr size_t WT_GO = WT_GIN + 2ull * 4352 * 1024;
constexpr size_t WT_MIN = WT_GO + 2ull * 1024 * 1024;
constexpr size_t WT_QUP = WT_MIN + 768ull * 1024;
constexpr size_t WT_KVUP = WT_QUP + 1536ull * 384;
constexpr size_t WT_MO = WT_KVUP + 2048ull * 256;
constexpr size_t WT_SIN = WT_MO + 1024ull * 1024;
constexpr size_t WT_SO = WT_SIN + 1536ull * 1024;
constexpr size_t WT_FIN = WT_SO + 1024ull * 1024;
constexpr size_t WT_FOUT = WT_FIN + 4ull * 5632 * 1024;
constexpr size_t WT_END = WT_FOUT + 4ull * 1024 * 2816;
constexpr size_t WS_H = al256(WS_WT + WT_END * 2);
constexpr size_t WS_BIG = al256(WS_H + (size_t)MT * 1024 * 2);
constexpr size_t BG_QKV = WS_BIG;
constexpr size_t BG_Z = al256(BG_QKV + (size_t)MT * 3072 * 2);
constexpr size_t BG_AB = al256(BG_Z + (size_t)MT * 1024 * 2);
constexpr size_t BG_KN = al256(BG_AB + (size_t)MT * 16 * 4);
constexpr size_t BG_TB = al256(BG_KN + (size_t)MT * 1024 * 2);
constexpr size_t BG_GB = al256(BG_TB + 8320ull * 4096 * 2);
constexpr size_t BG_END = al256(BG_GB + 8320ull * 128 * 4);
constexpr size_t BM_PROJ = WS_BIG;
constexpr size_t BM_CQ = al256(BM_PROJ + (size_t)MT * 768 * 2);
constexpr size_t BM_CKV = al256(BM_CQ + (size_t)MT * 384 * 2);
constexpr size_t BM_KR = al256(BM_CKV + (size_t)(MK + 64) * 256 * 2);
constexpr size_t BM_Q = al256(BM_KR + (size_t)(MK + 64) * 32 * 2);
constexpr size_t BM_KV = al256(BM_Q + (size_t)MT * 1536 * 2);
constexpr size_t BM_END = al256(BM_KV + (size_t)(MK + 64) * 2048 * 2);
constexpr size_t BS_PROJ = WS_BIG;
constexpr size_t BF_U = WS_BIG;
constexpr size_t BF_GD = al256(BF_U + (size_t)MT * DFF * 2);
constexpr size_t BF_UD = al256(BF_GD + (size_t)(MT / 32) * 4 * DFF * 4);
constexpr size_t BF_END = al256(BF_UD + (size_t)(MT / 32) * 2 * DFF * 4);
constexpr size_t WS_NEED = (BM_END > BF_END ? (BM_END > BG_END ? BM_END : BG_END) : (BF_END > BG_END ? BF_END : BG_END));

struct Args {
    const float* in[36];
    float* out;
    unsigned char* ws;
};

__device__ __forceinline__ float bf2f(bf16_t b) { return __uint_as_float(((unsigned)b) << 16); }
__device__ __forceinline__ bf16_t f2bf(float f) { unsigned u = __float_as_uint(f); u += 0x7FFFu + ((u >> 16) & 1u); return (bf16_t)(u >> 16); }
typedef __bf16 bf16v2_t __attribute__((ext_vector_type(2)));
__device__ __forceinline__ unsigned pk2(float lo, float hi) { const f32x2 v = {lo, hi}; const bf16v2_t b = __builtin_convertvector(v, bf16v2_t); return __builtin_bit_cast(unsigned, b); }
__device__ __forceinline__ float siluf(float x) { return x * __builtin_amdgcn_rcpf(1.f + __expf(-x)); }
__device__ __forceinline__ float sigmoidf_(float x) { return __builtin_amdgcn_rcpf(1.f + __expf(-x)); }
__device__ __forceinline__ int seq_of(int row) { return row < NTP ? (row >> 11) : 32 + ((row - NTP) >> 5); }
__device__ __forceinline__ void unpack8(const u32x4 v, float* f) {
    f[0] = __uint_as_float(v.x << 16); f[1] = __uint_as_float(v.x & 0xFFFF0000u);
    f[2] = __uint_as_float(v.y << 16); f[3] = __uint_as_float(v.y & 0xFFFF0000u);
    f[4] = __uint_as_float(v.z << 16); f[5] = __uint_as_float(v.z & 0xFFFF0000u);
    f[6] = __uint_as_float(v.w << 16); f[7] = __uint_as_float(v.w & 0xFFFF0000u);
}
__device__ __forceinline__ f32x4 bf4(const u32x2 t) { return (f32x4){__uint_as_float(t.x << 16), __uint_as_float(t.x & 0xFFFF0000u), __uint_as_float(t.y << 16), __uint_as_float(t.y & 0xFFFF0000u)}; }
__device__ __forceinline__ u32x4 pack8(const float* f) { u32x4 o; o.x = pk2(f[0], f[1]); o.y = pk2(f[2], f[3]); o.z = pk2(f[4], f[5]); o.w = pk2(f[6], f[7]); return o; }

__device__ __forceinline__ f32x4 mm16(const LAS bf16_t* A, int lda, const LAS bf16_t* Bt, int ldb, int K, f32x4 acc, int lane) {
    const int r = lane & 15, q = lane >> 4;
    const LAS bf16_t* ap = A + r * lda + q * 8; const LAS bf16_t* bp = Bt + r * ldb + q * 8;
    for (int k = 0; k < K; k += 32) {
        const bf16x8 av = *(const LAS bf16x8*)(ap + k);
        const bf16x8 bv = *(const LAS bf16x8*)(bp + k);
        acc = __builtin_amdgcn_mfma_f32_16x16x32_bf16(av, bv, acc, 0, 0, 0);
    }
    return acc;
}

template <int NK> __device__ __forceinline__ void ldfrag(const LAS bf16_t* M, int ld, bf16x8 (&f)[NK], int lane) {
    const LAS bf16_t* p = M + (lane & 15) * ld + (lane >> 4) * 8;
#pragma unroll
    for (int k = 0; k < NK; ++k) f[k] = *(const LAS bf16x8*)(p + 32 * k);
}
template <int NK> __device__ __forceinline__ f32x4 mm16b(const LAS bf16_t* A, int lda, const bf16x8 (&bf)[NK], f32x4 acc, int lane) {
    const LAS bf16_t* ap = A + (lane & 15) * lda + (lane >> 4) * 8;
#pragma unroll
    for (int k = 0; k < NK; ++k) acc = __builtin_amdgcn_mfma_f32_16x16x32_bf16(*(const LAS bf16x8*)(ap + 32 * k), bf[k], acc, 0, 0, 0);
    return acc;
}
template <int NK> __device__ __forceinline__ f32x4 mm16a(const bf16x8 (&af)[NK], const LAS bf16_t* Bt, int ldb, f32x4 acc, int lane) {
    const LAS bf16_t* bp = Bt + (lane & 15) * ldb + (lane >> 4) * 8;
#pragma unroll
    for (int k = 0; k < NK; ++k) acc = __builtin_amdgcn_mfma_f32_16x16x32_bf16(af[k], *(const LAS bf16x8*)(bp + 32 * k), acc, 0, 0, 0);
    return acc;
}

namespace pg8 {
constexpr int BM = 256, BK = 64, HALF = 128, HTB = HALF * BK * 2, STAGE_BYTES = 8 * HTB, NXCD = 8, WGM = 8;
__device__ __forceinline__ int lds_byte(int r, int c) { const int st = (r >> 4) * 2 + (c >> 5), rr = r & 15, cc = c & 31, ob = rr * 64 + cc * 2; return st * 1024 + (ob ^ (((ob >> 9) & 1) << 5)); }
__device__ __forceinline__ void stage_rc(int b, int& R, int& C) { const int st = b / 1024, sb = b % 1024, swz = sb ^ (((sb >> 9) & 1) << 5); R = (st >> 1) * 16 + swz / 64; C = (st & 1) * 32 + (swz % 64) / 2; }
__device__ __forceinline__ int perm32(int rho) { const int n = rho >> 4, i = rho & 15; return 8 * (i >> 2) + 4 * n + (i & 3); }
struct Unit { int pm, pn; };
struct StaticOrder {
    int nM, nN, nwg, G, c;
    __device__ void init(int M, int N, int G_, int c_) { nM = M / BM; nN = N / BM; nwg = nM * nN; G = G_; c = c_; }
    __device__ bool next(int i, Unit& u) const {
        const long L = (long)i * G + c; if (L >= nwg) return false;
        int wgid = (int)L; { const int q = nwg / NXCD, r = nwg % NXCD, xcd = wgid % NXCD, off = wgid / NXCD; wgid = (xcd < r ? xcd * (q + 1) : r * (q + 1) + (xcd - r) * q) + off; }
        const int nig = WGM * nN, gid = wgid / nig, fm = gid * WGM, gsz = (nM - fm) < WGM ? (nM - fm) : WGM;
        u.pm = fm + ((wgid % nig) % gsz); u.pn = (wgid % nig) / gsz; return true;
    }
};
}

struct Epi {
    int mode;
    float* X; const float* srcP; const float* srcS; const float* gate;
    bf16_t* o0; int ld0; int t1; bf16_t* o1; int ld1; int t2; float* o2;
    float* ud; const float* cw; const float* cb; const LAS bf16_t* cwl;
    __device__ __forceinline__ void operator()(const f32x4 (&acc)[2][2][4][2], const pg8::Unit& u, int wr, int wc, int fr, int fq) const {
        const int row0 = u.pm * 256 + wr * 64 + fr;
        if (mode == 0) {
            const int c0 = u.pn * 256 + wc * 32 + 8 * fq;
            bf16_t* X16 = (bf16_t*)X;
            const bool uni = u.pm < 256;
            f32x4 gU[2][2];
            if (uni) { const float* gp = gate + (size_t)seq_of(u.pm * 256) * 6144 + c0;
#pragma unroll
                for (int bj = 0; bj < 2; ++bj)
#pragma unroll
                    for (int n = 0; n < 2; ++n) gU[bj][n] = *(const f32x4*)(gp + bj * 128 + 4 * n); }
            if (srcP) {
#pragma unroll
                for (int am = 0; am < 4; ++am) {
                    const int ai = am >> 1, m0 = (am & 1) * 2;
                    f32x4 xv[2][2][2];
#pragma unroll
                    for (int mm = 0; mm < 2; ++mm) {
                        const int row = row0 + ai * 128 + (m0 + mm) * 16;
                        const float* sp = (row < NTP ? srcP + (size_t)row * D : srcS + (size_t)(row - NTP) * D) + c0;
#pragma unroll
                        for (int bj = 0; bj < 2; ++bj)
#pragma unroll
                            for (int n = 0; n < 2; ++n) xv[mm][bj][n] = *(const f32x4*)(sp + bj * 128 + 4 * n);
                    }
#pragma unroll
                    for (int mm = 0; mm < 2; ++mm) {
                        const int row = row0 + ai * 128 + (m0 + mm) * 16;
                        const float* gp = gate + (size_t)seq_of(row) * 6144 + c0;
#pragma unroll
                        for (int bj = 0; bj < 2; ++bj) {
                            const f32x4 g0 = uni ? gU[bj][0] : *(const f32x4*)(gp + bj * 128), g1 = uni ? gU[bj][1] : *(const f32x4*)(gp + bj * 128 + 4);
                            const f32x4 y0 = xv[mm][bj][0] + g0 * acc[ai][bj][m0 + mm][0], y1 = xv[mm][bj][1] + g1 * acc[ai][bj][m0 + mm][1];
                            u32x4 w; w.x = pk2(y0[0], y0[1]); w.y = pk2(y0[2], y0[3]); w.z = pk2(y1[0], y1[1]); w.w = pk2(y1[2], y1[3]);
                            *(u32x4*)(X16 + (size_t)row * XS + c0 + bj * 128) = w;
                        }
                    }
                    __builtin_amdgcn_sched_barrier(0);
                }
            } else {
#pragma unroll
                for (int ai = 0; ai < 2; ++ai) {
                    u32x4 xv[4][2];
#pragma unroll
                    for (int m = 0; m < 4; ++m)
#pragma unroll
                        for (int bj = 0; bj < 2; ++bj) xv[m][bj] = *(const u32x4*)(X16 + (size_t)(row0 + ai * 128 + m * 16) * XS + c0 + bj * 128);
#pragma unroll
                    for (int m = 0; m < 4; ++m) {
                        const int row = row0 + ai * 128 + m * 16;
                        const float* gp = gate + (size_t)seq_of(row) * 6144 + c0;
#pragma unroll
                        for (int bj = 0; bj < 2; ++bj) {
                            const f32x4 g0 = uni ? gU[bj][0] : *(const f32x4*)(gp + bj * 128), g1 = uni ? gU[bj][1] : *(const f32x4*)(gp + bj * 128 + 4);
                            float x[8]; unpack8(xv[m][bj], x);
                            const f32x4 a0 = acc[ai][bj][m][0], a1 = acc[ai][bj][m][1];
                            u32x4 w; w.x = pk2(x[0] + g0[0] * a0[0], x[1] + g0[1] * a0[1]); w.y = pk2(x[2] + g0[2] * a0[2], x[3] + g0[3] * a0[3]);
                            w.z = pk2(x[4] + g1[0] * a1[0], x[5] + g1[1] * a1[1]); w.w = pk2(x[6] + g1[2] * a1[2], x[7] + g1[3] * a1[3]);
                            *(u32x4*)(X16 + (size_t)row * XS + c0 + bj * 128) = w;
                        }
                    }
                    __builtin_amdgcn_sched_barrier(0);
                }
            }
        } else if (mode == 2) {
            const int c0 = u.pn * 128 + wc * 32 + 8 * fq;
            f32x4 w0[2], w1[2], w2[2], bb[2];
#pragma unroll
            for (int n = 0; n < 2; ++n) { w0[n] = bf4(*(const LAS u32x2*)(cwl + c0 + 4 * n)); w1[n] = bf4(*(const LAS u32x2*)(cwl + DFF + c0 + 4 * n)); w2[n] = bf4(*(const LAS u32x2*)(cwl + 2 * DFF + c0 + 4 * n)); bb[n] = bf4(*(const LAS u32x2*)(cwl + 3 * DFF + c0 + 4 * n)); }
#pragma unroll
            for (int ai = 0; ai < 2; ++ai) {
                f32x4 p1[2] = {(f32x4){0.f, 0.f, 0.f, 0.f}, (f32x4){0.f, 0.f, 0.f, 0.f}}, p2[2] = {(f32x4){0.f, 0.f, 0.f, 0.f}, (f32x4){0.f, 0.f, 0.f, 0.f}};
#pragma unroll
                for (int m = 0; m < 4; ++m) {
                    const int row = row0 + ai * 128 + m * 16;
                    float hv[8];
#pragma unroll
                    for (int n = 0; n < 2; ++n) {
                        const f32x4 g = acc[ai][0][m][n], up = acc[ai][1][m][n];
                        f32x4 c1, c2;
#pragma unroll
                        for (int j = 0; j < 4; ++j) {
                            c1[j] = __int_as_float(__builtin_amdgcn_update_dpp(0, __float_as_int(g[j]), 0x121, 0xF, 0xF, false));
                            c2[j] = __int_as_float(__builtin_amdgcn_update_dpp(0, __float_as_int(g[j]), 0x122, 0xF, 0xF, false)); }
                        f32x4 g1v, g2v;
#pragma unroll
                        for (int j = 0; j < 4; ++j) { g1v[j] = fr >= 1 ? c1[j] : p1[n][j]; g2v[j] = fr >= 2 ? c2[j] : p2[n][j]; }
#pragma unroll
                        for (int hh = 0; hh < 2; ++hh) {
                            const f32x2 gg = (f32x2){g[2 * hh], g[2 * hh + 1]}, a1 = (f32x2){g1v[2 * hh], g1v[2 * hh + 1]}, a2 = (f32x2){g2v[2 * hh], g2v[2 * hh + 1]};
                            const f32x2 t0 = (f32x2){w0[n][2 * hh], w0[n][2 * hh + 1]}, t1 = (f32x2){w1[n][2 * hh], w1[n][2 * hh + 1]}, t2 = (f32x2){w2[n][2 * hh], w2[n][2 * hh + 1]};
                            const f32x2 y = t0 * a2 + (t1 * a1 + (t2 * gg + (f32x2){bb[n][2 * hh], bb[n][2 * hh + 1]}));
                            const f32x2 t = y * (-1.4426950408889634f);
                            f32x2 d = (f32x2){__builtin_amdgcn_exp2f(t.x), __builtin_amdgcn_exp2f(t.y)} + 1.0f;
                            d = (f32x2){__builtin_amdgcn_rcpf(d.x), __builtin_amdgcn_rcpf(d.y)};
                            const f32x2 hvv = y * d * (f32x2){up[2 * hh], up[2 * hh + 1]};
                            hv[4 * n + 2 * hh] = hvv.x; hv[4 * n + 2 * hh + 1] = hvv.y;
                        }
                        p1[n] = c1; p2[n] = c2;
                    }
                    *(u32x4*)(o0 + (size_t)row * DFF + c0) = pack8(hv);
                    const int rr = (m & 1) * 16 + fr;
                    if (rr >= 30 || rr < 2) {
                        float* gd = o2 + ((size_t)(row >> 5) * 4 + (rr >= 30 ? rr - 30 : 2 + rr)) * DFF + c0;
                        *(f32x4*)gd = acc[ai][0][m][0]; *(f32x4*)(gd + 4) = acc[ai][0][m][1];
                        if (rr < 2) { float* up_ = ud + ((size_t)(row >> 5) * 2 + rr) * DFF + c0; *(f32x4*)up_ = acc[ai][1][m][0]; *(f32x4*)(up_ + 4) = acc[ai][1][m][1]; }
                    }
                    __builtin_amdgcn_sched_barrier(0);
                }
            }
        } else {
            if (u.pn < t2) {
                bf16_t* base; int ld, colt;
                if (u.pn < t1) { base = o0; ld = ld0; colt = u.pn * 256; } else { base = o1; ld = ld1; colt = (u.pn - t1) * 256; }
                const int col0 = colt + wc * 32 + 8 * fq;
#pragma unroll
                for (int ai = 0; ai < 2; ++ai)
#pragma unroll
                    for (int m = 0; m < 4; ++m) {
                        bf16_t* rowp = base + (size_t)(row0 + ai * 128 + m * 16) * ld + col0;
#pragma unroll
                        for (int bj = 0; bj < 2; ++bj) {
                            const f32x4 v0 = acc[ai][bj][m][0], v1 = acc[ai][bj][m][1];
                            u32x4 w; w.x = pk2(v0[0], v0[1]); w.y = pk2(v0[2], v0[3]); w.z = pk2(v1[0], v1[1]); w.w = pk2(v1[2], v1[3]);
                            *(u32x4*)(rowp + bj * 128) = w;
                        }
                    }
            } else if (wc == 0 && fq < 2) {
#pragma unroll
                for (int ai = 0; ai < 2; ++ai)
#pragma unroll
                    for (int m = 0; m < 4; ++m) {
                        float* rp = o2 + (size_t)(row0 + ai * 128 + m * 16) * 16 + 8 * fq;
                        *(f32x4*)rp = acc[ai][0][m][0]; *(f32x4*)(rp + 4) = acc[ai][0][m][1];
                    }
            }
        }
    }
};

__device__ __forceinline__ void gemm_phase(LAS unsigned char* lds, const bf16_t* A, const bf16_t* Bt, int M, int N, int K, const Epi& E) {
    using namespace pg8;
    int tid_ = tidx(); int bid_ = bidx();
    const int tid = tid_, wid = __builtin_amdgcn_readfirstlane(tid >> 6), lane = tid & 63, wr = wid >> 2, wc = wid & 3, fr = lane & 15, fq = lane >> 4;
    const int nt = K / BK;
    const bool perm = true;
    if (E.mode == 2) {
        LAS bf16_t* cwl = (LAS bf16_t*)(lds + CWL_OFF);
        for (int idx = tid; idx < 4 * DFF; idx += NTHREADS) cwl[idx] = f2bf(idx < 3 * DFF ? E.cw[idx] : E.cb[idx - 3 * DFF]);
        asm volatile("s_waitcnt lgkmcnt(0)" ::: "memory");
    }
    StaticOrder S; S.init(M, N, gridDim.x, bid_);
    unsigned voffA[2], voffB[2];
#pragma unroll
    for (int i = 0; i < 2; ++i) { int R, C; stage_rc(tid * 16 + i * 8192, R, C); const int Rb = perm ? ((R & ~31) + perm32(R & 31)) : R;
        voffA[i] = (unsigned)(R * K + C) * 2u; voffB[i] = (unsigned)(Rb * K + C) * 2u; }
    const size_t kstep = (size_t)(BK * 2);
    const size_t hstep = (size_t)HALF * K * 2;
    const size_t tstep = 2 * hstep;
    const unsigned ldsw = (unsigned)wid * 1024u;
    const int aoff = lds_byte(wr * 64 + fr, fq * 8), boff = lds_byte(wc * 32 + fr, fq * 8);
#define PG8_SA(b, h) (((b) * 2 + (h)) * HTB)
#define PG8_SB(b, h) ((4 + (b) * 2 + (h)) * HTB)
#define PG8_STAGE(bufoff, gbase, voff) do { _Pragma("unroll") for (int _i = 0; _i < 2; ++_i) \
        __builtin_amdgcn_global_load_lds((const unsigned*)((const char*)(gbase) + (voff)[_i]), (LAS unsigned*)(lds + (bufoff) + ldsw + _i * 8192), 16, 0, 0); } while (0)
#define PG8_LDA(dst, b, h) do { _Pragma("unroll") for (int m = 0; m < 4; ++m) _Pragma("unroll") for (int k = 0; k < 2; ++k) dst[m][k] = *(const LAS bf16x8*)(lds + PG8_SA(b, h) + aoff + m * 2048 + k * 1024); } while (0)
#define PG8_LDB(dst, b, h) do { _Pragma("unroll") for (int n = 0; n < 2; ++n) _Pragma("unroll") for (int k = 0; k < 2; ++k) dst[n][k] = *(const LAS bf16x8*)(lds + PG8_SB(b, h) + boff + n * 2048 + k * 1024); } while (0)
#define PG8_MMA(ai, bj, At, Bt_) do { __builtin_amdgcn_s_setprio(1); _Pragma("unroll") for (int m = 0; m < 4; ++m) _Pragma("unroll") for (int n = 0; n < 2; ++n) _Pragma("unroll") for (int k = 0; k < 2; ++k) \
        acc[ai][bj][m][n] = __builtin_amdgcn_mfma_f32_16x16x32_bf16(Bt_[n][k], At[m][k], acc[ai][bj][m][n], 0, 0, 0); __builtin_amdgcn_s_setprio(0); } while (0)
#define PG8_WAIT_V(n) asm volatile("s_waitcnt vmcnt(" #n ")" ::: "memory")
#define PG8_WAIT_L(n) asm volatile("s_waitcnt lgkmcnt(" #n ")" ::: "memory")
#define PG8_BAR __builtin_amdgcn_s_barrier()
#define PG8_SCHED __builtin_amdgcn_sched_barrier(0)
    Unit cur, nxt; int ui = 0;
    if (!S.next(0, cur)) return;
    f32x4 acc[2][2][4][2];
#pragma unroll
    for (int a = 0; a < 2; ++a)
#pragma unroll
        for (int b = 0; b < 2; ++b)
#pragma unroll
            for (int m = 0; m < 4; ++m)
#pragma unroll
                for (int n = 0; n < 2; ++n) acc[a][b][m][n] = (f32x4){0.f, 0.f, 0.f, 0.f};
    bf16x8 At[4][2], B0[2][2], B1[2][2];
    const char* cA = (const char*)A + (size_t)cur.pm * tstep; const char* cB = (const char*)Bt + (size_t)cur.pn * tstep;
    PG8_STAGE(PG8_SB(0, 0), cB, voffB); PG8_STAGE(PG8_SB(0, 1), cB + hstep, voffB); PG8_STAGE(PG8_SA(0, 0), cA, voffA); PG8_STAGE(PG8_SA(0, 1), cA + hstep, voffA);
    if (wr == 1) PG8_BAR;
    PG8_WAIT_V(2); PG8_BAR;
    PG8_STAGE(PG8_SB(1, 0), cB + kstep, voffB); PG8_STAGE(PG8_SA(1, 0), cA + kstep, voffA); PG8_STAGE(PG8_SB(1, 1), cB + hstep + kstep, voffB);
    PG8_WAIT_V(6); PG8_BAR;
    for (;;) {
        const bool has_next = S.next(ui + 1, nxt);
        const char* nA = has_next ? (const char*)A + (size_t)nxt.pm * tstep : cA; const char* nB = has_next ? (const char*)Bt + (size_t)nxt.pn * tstep : cB;
        for (int t = 0; t < nt; t += 2) {
            const bool last = (t == nt - 2);
            const char* a1 = cA + (size_t)(t + 1) * kstep;
            const char* a2 = last ? nA : cA + (size_t)(t + 2) * kstep; const char* b2 = last ? nB : cB + (size_t)(t + 2) * kstep;
            const char* a3 = a2 + kstep; const char* b3 = b2 + kstep;
            PG8_LDB(B0, 0, 0); PG8_LDB(B1, 0, 1); PG8_SCHED; PG8_LDA(At, 0, 0); PG8_STAGE(PG8_SA(1, 1), a1 + hstep, voffA);
            PG8_WAIT_V(8); PG8_WAIT_L(0); PG8_BAR; PG8_MMA(0, 0, At, B0); PG8_MMA(0, 1, At, B1); PG8_BAR; PG8_SCHED;
            PG8_LDA(At, 0, 1); PG8_STAGE(PG8_SB(0, 0), b2, voffB); PG8_STAGE(PG8_SB(0, 1), b2 + hstep, voffB); PG8_STAGE(PG8_SA(0, 0), a2, voffA);
            PG8_WAIT_V(8); PG8_WAIT_L(0); PG8_BAR; PG8_MMA(1, 0, At, B0); PG8_MMA(1, 1, At, B1); PG8_BAR; PG8_SCHED;
            PG8_LDB(B0, 1, 0); PG8_LDB(B1, 1, 1); PG8_SCHED; PG8_LDA(At, 1, 0); PG8_STAGE(PG8_SA(0, 1), a2 + hstep, voffA);
            PG8_WAIT_V(8); PG8_WAIT_L(0); PG8_BAR; PG8_MMA(0, 0, At, B0); PG8_MMA(0, 1, At, B1); PG8_BAR; PG8_SCHED;
            PG8_LDA(At, 1, 1); PG8_STAGE(PG8_SB(1, 0), b3, voffB); PG8_STAGE(PG8_SB(1, 1), b3 + hstep, voffB); PG8_STAGE(PG8_SA(1, 0), a3, voffA);
            PG8_WAIT_V(8); PG8_WAIT_L(0); PG8_BAR; PG8_MMA(1, 0, At, B0); PG8_MMA(1, 1, At, B1); PG8_BAR; PG8_SCHED;
        }
        if (wr == 0) PG8_BAR;
        E(acc, cur, wr, wc, fr, fq);
        if (!has_next) break;
#pragma unroll
        for (int a = 0; a < 2; ++a)
#pragma unroll
            for (int b = 0; b < 2; ++b)
#pragma unroll
                for (int m = 0; m < 4; ++m)
#pragma unroll
                    for (int n = 0; n < 2; ++n) acc[a][b][m][n] = (f32x4){0.f, 0.f, 0.f, 0.f};
        cur = nxt; cA = nA; cB = nB; ++ui;
        if (wr == 1) PG8_BAR;
    }
    PG8_WAIT_V(0);
    PG8_BAR;
#undef PG8_SA
#undef PG8_SB
#undef PG8_STAGE
#undef PG8_LDA
#undef PG8_LDB
#undef PG8_MMA
#undef PG8_WAIT_V
#undef PG8_WAIT_L
#undef PG8_BAR
#undef PG8_SCHED
}

__device__ __forceinline__ void transpose_item(const float* W, int ldw, int K, int nblk, bf16_t* WT, LAS float* scr, int item, int lane, bool ffn_il = false) {
    const int kb = item / nblk, nb = item % nblk, k0 = 64 * kb, n0 = 32 * nb;
    const int d0 = !ffn_il ? n0 : (n0 < DFF ? 256 * (n0 >> 7) + (n0 & 127) : 256 * ((n0 - DFF) >> 7) + 128 + ((n0 - DFF) & 127));
#pragma unroll 8
    for (int i = 0; i < 32; ++i) { const int kk = 2 * i + (lane >> 5); scr[kk * 33 + (lane & 31)] = W[(size_t)(k0 + kk) * ldw + n0 + (lane & 31)]; }
    asm volatile("s_waitcnt lgkmcnt(0)" ::: "memory");
    const int c = lane & 7;
#pragma unroll
    for (int j = 0; j < 4; ++j) { const int n = (lane >> 3) + 8 * j; const LAS float* s = scr + (8 * c) * 33 + n;
        u32x4 o; o.x = pk2(s[0 * 33], s[1 * 33]); o.y = pk2(s[2 * 33], s[3 * 33]); o.z = pk2(s[4 * 33], s[5 * 33]); o.w = pk2(s[6 * 33], s[7 * 33]);
        *(u32x4*)(WT + (size_t)(d0 + n) * K + k0 + 8 * c) = o; }
    asm volatile("s_waitcnt lgkmcnt(0)" ::: "memory");
}

__device__ __forceinline__ void transpose_item64(const float* W, int ldw, int K, int nblk, bf16_t* WT, LAS float* scr, int item, int lane, bool ffn_il = false) {
    const int kb = item / nblk, nb = item % nblk, k0 = 64 * kb, n0 = 64 * nb;
    const int d0 = !ffn_il ? n0 : (n0 < DFF ? 256 * (n0 >> 7) + (n0 & 127) : 256 * ((n0 - DFF) >> 7) + 128 + ((n0 - DFF) & 127));
    const int c4 = (lane & 15) * 4, kq = lane >> 4;
    f32x4 v[16];
#pragma unroll
    for (int i = 0; i < 16; ++i) v[i] = *(const f32x4*)(W + (size_t)(k0 + 4 * i + kq) * ldw + n0 + c4);
#pragma unroll
    for (int i = 0; i < 16; ++i) { LAS float* d = scr + (4 * i + kq) * 65 + c4; d[0] = v[i].x; d[1] = v[i].y; d[2] = v[i].z; d[3] = v[i].w; }
    asm volatile("s_waitcnt lgkmcnt(0)" ::: "memory");
    const int c = lane & 7;
#pragma unroll
    for (int j = 0; j < 8; ++j) { const int n = (lane >> 3) + 8 * j; const LAS float* s = scr + (8 * c) * 65 + n;
        u32x4 o; o.x = pk2(s[0 * 65], s[1 * 65]); o.y = pk2(s[2 * 65], s[3 * 65]); o.z = pk2(s[4 * 65], s[5 * 65]); o.w = pk2(s[6 * 65], s[7 * 65]);
        *(u32x4*)(WT + (size_t)(d0 + n) * K + k0 + 8 * c) = o; }
    asm volatile("s_waitcnt lgkmcnt(0)" ::: "memory");
}

__device__ __forceinline__ void prep_phase(const Args& a, LAS unsigned char* lds) {
    const int tid = tidx(), lane = tid & 63, wave = tid >> 6;
    bf16_t* WT = (bf16_t*)(a.ws + WS_WT);
    if (bidx() < 192) {
        const int bb = bidx(), l = bb / 48, cl = tid & 127, cq = tid >> 7, n = (bb % 48) * 128 + cl;
        LAS float* cs = (LAS float*)lds;
        LAS float* red = (LAS float*)(lds + 49152);
        float acc[48];
#pragma unroll
        for (int s = 0; s < 48; ++s) acc[s] = 0.f;
        const float* w = a.in[11] + (size_t)l * 1024 * 6144 + n;
        for (int kc = 0; kc < 4; ++kc) {
            __syncthreads();
            for (int idx = tid; idx < 48 * 256; idx += NTHREADS) { const int s = idx >> 8, k = idx & 255;
                const float c = s < 32 ? a.in[2][s * 1024 + kc * 256 + k] : a.in[3][(s - 32) * 1024 + kc * 256 + k];
                cs[k * 48 + s] = siluf(c); }
            __syncthreads();
#pragma unroll 1
            for (int k8 = 0; k8 < 64; k8 += 8) {
                float wv[8];
#pragma unroll
                for (int u = 0; u < 8; ++u) wv[u] = w[(size_t)(kc * 256 + cq * 64 + k8 + u) * 6144];
#pragma unroll
                for (int u = 0; u < 8; ++u) {
                    const LAS f32x4* cp = (const LAS f32x4*)(cs + (cq * 64 + k8 + u) * 48);
#pragma unroll
                    for (int s4 = 0; s4 < 12; ++s4) { const f32x4 c = cp[s4]; acc[4 * s4] += c.x * wv[u]; acc[4 * s4 + 1] += c.y * wv[u]; acc[4 * s4 + 2] += c.z * wv[u]; acc[4 * s4 + 3] += c.w * wv[u]; }
                }
            }
        }
#pragma unroll
        for (int s = 0; s < 48; ++s) red[(cq * 48 + s) * 128 + cl] = acc[s];
        __syncthreads();
        float* mod = (float*)(a.ws + WS_MOD) + (size_t)l * 48 * 6144 + (bb % 48) * 128;
        for (int idx = tid; idx < 48 * 128; idx += NTHREADS) { const int s = idx >> 7, c = idx & 127;
            mod[(size_t)s * 6144 + c] = red[(0 * 48 + s) * 128 + c] + red[(1 * 48 + s) * 128 + c] + red[(2 * 48 + s) * 128 + c] + red[(3 * 48 + s) * 128 + c] + a.in[12][l * 6144 + (bb % 48) * 128 + c]; }
        __syncthreads();
    }
    {
        LAS float* scr = (LAS float*)(lds + wave * 16640);
        const int gw = bidx() * 8 + wave, NGW = gridDim.x * 8;
        constexpr int I_GIN = 16 * 64, I_SQ = 16 * 16, I_MIN = 16 * 21, I_QUP = 6 * 24, I_KVUP = 4 * 32, I_SIN = 16 * 24, I_FIN = 16 * 88, I_FOUT = 44 * 16;
        constexpr int NITEMS = 2 * I_GIN + 2 * I_SQ + I_MIN + I_QUP + I_KVUP + I_SQ + I_SIN + I_SQ + 4 * I_FIN + 4 * I_FOUT;
        for (int it = gw; it < NITEMS; it += NGW) {
            int r = it;
            if (r < 4 * I_FIN) { const int s = r / I_FIN; transpose_item64(a.in[32] + (size_t)s * 1024 * 5632, 5632, 1024, 88, WT + WT_FIN + (size_t)s * 5632 * 1024, scr, r % I_FIN, lane, true); continue; } r -= 4 * I_FIN;
            if (r < 4 * I_FOUT) { const int s = r / I_FOUT; transpose_item64(a.in[35] + (size_t)s * 2816 * 1024, 1024, 2816, 16, WT + WT_FOUT + (size_t)s * 1024 * 2816, scr, r % I_FOUT, lane); continue; } r -= 4 * I_FOUT;
            if (r < 2 * I_GIN) { const int s = r / I_GIN; transpose_item64(a.in[16] + (size_t)s * 1024 * 4112, 4112, 1024, 64, WT + WT_GIN + (size_t)s * 4352 * 1024, scr, r % I_GIN, lane); continue; } r -= 2 * I_GIN;
            if (r < 2 * I_SQ) { const int s = r / I_SQ; transpose_item64(a.in[21] + (size_t)s * 1024 * 1024, 1024, 1024, 16, WT + WT_GO + (size_t)s * 1024 * 1024, scr, r % I_SQ, lane); continue; } r -= 2 * I_SQ;
            if (r < I_MIN) { transpose_item(a.in[22], 672, 1024, 21, WT + WT_MIN, scr, r, lane); continue; } r -= I_MIN;
            if (r < I_QUP) { transpose_item64(a.in[25], 1536, 384, 24, WT + WT_QUP, scr, r, lane); continue; } r -= I_QUP;
            if (r < I_KVUP) { transpose_item64(a.in[26], 2048, 256, 32, WT + WT_KVUP, scr, r, lane); continue; } r -= I_KVUP;
            if (r < I_SQ) { transpose_item64(a.in[27], 1024, 1024, 16, WT + WT_MO, scr, r, lane); continue; } r -= I_SQ;
            if (r < I_SIN) { transpose_item64(a.in[28], 1536, 1024, 24, WT + WT_SIN, scr, r, lane); continue; } r -= I_SIN;
            transpose_item64(a.in[30], 1024, 1024, 16, WT + WT_SO, scr, r, lane);
        }
    }
    const size_t gt = (size_t)bidx() * NTHREADS + tid, NGT = (size_t)gridDim.x * NTHREADS;
    for (size_t i = gt; i < 2ull * 256 * 1024; i += NGT) { const int s = (int)(i / (256 * 1024)), rr = (int)((i / 1024) % 256), k = (int)(i % 1024);
        const float v = rr < 16 ? a.in[16][(size_t)s * 1024 * 4112 + (size_t)k * 4112 + 4096 + rr] : 0.f;
        WT[WT_GIN + (size_t)s * 4352 * 1024 + (size_t)(4096 + rr) * 1024 + k] = f2bf(v); }
    for (size_t i = gt; i < 96ull * 1024; i += NGT) WT[WT_MIN + 672ull * 1024 + i] = 0;
    { f32x2* rope = (f32x2*)(a.ws + WS_ROPE);
      for (size_t i = gt; i < 2048ull * 16; i += NGT) { const int pos = (int)(i >> 4), j = (int)(i & 15);
          const float inv = powf(10000.f, -(float)j / 16.f); const float ang = (float)pos * inv; rope[i] = (f32x2){cosf(ang), sinf(ang)}; } }
    { float* bt = (float*)(a.ws + WS_BIAS);
      for (size_t i = gt; i < 16ull * 256; i += NGT) { const int h = (int)(i >> 8), idx = (int)(i & 255); const int n = idx - 63; const int an = n < 0 ? -n : n;
          int bucket = (n < 0 ? 16 : 0);
          if (an < 8) bucket += an; else { int lb = 8 + (31 - __clz(an * an)) - 6; bucket += lb < 15 ? lb : 15; }
          bt[i] = a.in[31][bucket * 16 + h] * 1.4426950408889634f; } }
    { bf16_t* kc = (bf16_t*)(a.ws + WS_SWAKC); bf16_t* vc = (bf16_t*)(a.ws + WS_SWAVC);
      for (size_t i = gt; i < 16ull * 128 * 256; i += NGT) { kc[i] = f2bf(a.in[8][i]); vc[i] = f2bf(a.in[9][i]); } }
}

__device__ __forceinline__ void norm_phase(const Args& a, bool from_input, const float* gain, int layer, int shidx) {
    const int lane = tidx() & 63, gw = bidx() * 8 + (tidx() >> 6), NGW = gridDim.x * 8;
    const float* X = a.out; bf16_t* H = (bf16_t*)(a.ws + WS_H);
    const float* mod = (const float*)(a.ws + WS_MOD) + (size_t)layer * 48 * 6144;
    f32x4 g[4];
#pragma unroll
    for (int j = 0; j < 4; ++j) g[j] = *(const f32x4*)(gain + 4 * lane + 256 * j);
#pragma unroll 1
    for (int row0 = gw * 4; row0 < MT; row0 += NGW * 4) {
        f32x4 v[4][4];
        if (from_input) {
            const float* xr = row0 < NTP ? a.in[0] + (size_t)row0 * D : a.in[1] + (size_t)(row0 - NTP) * D;
#pragma unroll
            for (int rr = 0; rr < 4; ++rr)
#pragma unroll
                for (int j = 0; j < 4; ++j) v[rr][j] = *(const f32x4*)(xr + (size_t)rr * D + 4 * lane + 256 * j);
        } else {
            const bf16_t* xr = (const bf16_t*)X + (size_t)row0 * XS;
            u32x2 t[4][4];
#pragma unroll
            for (int rr = 0; rr < 4; ++rr)
#pragma unroll
                for (int j = 0; j < 4; ++j) t[rr][j] = *(const u32x2*)(xr + (size_t)rr * XS + 4 * lane + 256 * j);
#pragma unroll
            for (int rr = 0; rr < 4; ++rr)
#pragma unroll
                for (int j = 0; j < 4; ++j) v[rr][j] = (f32x4){__uint_as_float(t[rr][j].x << 16), __uint_as_float(t[rr][j].x & 0xFFFF0000u), __uint_as_float(t[rr][j].y << 16), __uint_as_float(t[rr][j].y & 0xFFFF0000u)};
        }
        const float* mp = mod + (size_t)seq_of(row0) * 6144 + shidx * 1024;
        f32x4 sh[4], sc[4];
#pragma unroll
        for (int j = 0; j < 4; ++j) { sh[j] = *(const f32x4*)(mp + 4 * lane + 256 * j); sc[j] = g[j] * (*(const f32x4*)(mp + 1024 + 4 * lane + 256 * j) + 1.f); }
#pragma unroll
        for (int rr = 0; rr < 4; ++rr) {
            float ss = 0.f;
#pragma unroll
            for (int j = 0; j < 4; ++j) ss += v[rr][j].x * v[rr][j].x + v[rr][j].y * v[rr][j].y + v[rr][j].z * v[rr][j].z + v[rr][j].w * v[rr][j].w;
#pragma unroll
            for (int o = 1; o < 64; o <<= 1) ss += __shfl_xor(ss, o);
            const float rstd = rsqrtf(ss * (1.f / D) + EPS);
#pragma unroll
            for (int j = 0; j < 4; ++j) {
                const f32x4 y = v[rr][j] * rstd * sc[j] + sh[j];
                u32x2 o; o.x = pk2(y.x, y.y); o.y = pk2(y.z, y.w);
                *(u32x2*)(H + (size_t)(row0 + rr) * D + 4 * lane + 256 * j) = o;
            }
        }
    }
}

__device__ __forceinline__ void final_norm_phase(const Args& a) {
    const int lane = tidx() & 63, gw = bidx() * 8 + (tidx() >> 6), NGW = gridDim.x * 8;
    f32x4 g[4];
#pragma unroll
    for (int j = 0; j < 4; ++j) g[j] = *(const f32x4*)(a.in[15] + 4 * lane + 256 * j);
#pragma unroll 1
    for (int row0 = gw * 4; row0 < MT; row0 += NGW * 4) {
        float* xr = a.out + (size_t)row0 * D;
        f32x4 v[4][4];
        {
            const bf16_t* xb = (const bf16_t*)a.out + (size_t)row0 * XS;
            u32x2 t[4][4];
#pragma unroll
            for (int rr = 0; rr < 4; ++rr)
#pragma unroll
                for (int j = 0; j < 4; ++j) t[rr][j] = *(const u32x2*)(xb + (size_t)rr * XS + 4 * lane + 256 * j);
#pragma unroll
            for (int rr = 0; rr < 4; ++rr)
#pragma unroll
                for (int j = 0; j < 4; ++j) v[rr][j] = (f32x4){__uint_as_float(t[rr][j].x << 16), __uint_as_float(t[rr][j].x & 0xFFFF0000u), __uint_as_float(t[rr][j].y << 16), __uint_as_float(t[rr][j].y & 0xFFFF0000u)};
        }
        asm volatile("s_waitcnt vmcnt(0)" ::: "memory");
#pragma unroll
        for (int rr = 0; rr < 4; ++rr) {
            float ss = 0.f;
#pragma unroll
            for (int j = 0; j < 4; ++j) ss += v[rr][j].x * v[rr][j].x + v[rr][j].y * v[rr][j].y + v[rr][j].z * v[rr][j].z + v[rr][j].w * v[rr][j].w;
#pragma unroll
            for (int o = 1; o < 64; o <<= 1) ss += __shfl_xor(ss, o);
            const float rstd = rsqrtf(ss * (1.f / D) + EPS);
#pragma unroll
            for (int j = 0; j < 4; ++j) *(f32x4*)(xr + (size_t)rr * D + 4 * lane + 256 * j) = v[rr][j] * rstd * g[j];
        }
    }
}

__device__ __forceinline__ void gdn_row16(const bf16_t* QKV, const float* hist, bool samp, size_t row0, int tt, int col0, float* x) {
    if (tt >= 0) { const bf16_t* p = QKV + (row0 + tt) * 3072 + col0; unpack8(*(const u32x4*)p, x); unpack8(*(const u32x4*)(p + 8), x + 8); }
    else if (samp) { const float* p = hist + (size_t)(3 + tt) * 3072 + col0;
#pragma unroll
        for (int e = 0; e < 16; e += 4) { const f32x4 v = *(const f32x4*)(p + e); x[e] = v.x; x[e + 1] = v.y; x[e + 2] = v.z; x[e + 3] = v.w; } }
    else {
#pragma unroll
        for (int e = 0; e < 16; ++e) x[e] = 0.f; }
}

__device__ __forceinline__ void gdn_pre_phase(const Args& a, LAS unsigned char* lds, int slot) {
    const int tid0 = tidx();
    const int lane0 = tid0 & 63, wave = __builtin_amdgcn_readfirstlane(tid0 >> 6);
#define G1_LANEVARS int lane = lane0; OPAQUE_V(lane); const int r = lane & 15, quad = lane >> 4; (void)r; (void)quad;
    LAS unsigned char* wl = lds + wave * 18736;
    LAS bf16_t* Ks = (LAS bf16_t*)wl;
    LAS float* AT = (LAS float*)wl;
    LAS float* GCs = (LAS float*)(wl + 18224); LAS float* BEs = GCs + 64;
    const bf16_t* QKV = (const bf16_t*)(a.ws + BG_QKV); const float* AB = (const float*)(a.ws + BG_AB);
    bf16_t* Hq = (bf16_t*)(a.ws + WS_H); bf16_t* KN = (bf16_t*)(a.ws + BG_KN); bf16_t* TB = (bf16_t*)(a.ws + BG_TB); float* GB = (float*)(a.ws + BG_GB);
    const float* convw = a.in[17] + (size_t)slot * 4 * 3072;

    for (size_t i = (size_t)bidx() * NTHREADS + tid0; i < 48ull * 3 * 3072; i += (size_t)gridDim.x * NTHREADS) {
        const int s = (int)(i / (3 * 3072)), j = (int)((i / 3072) % 3), c = (int)(i % 3072);
        if (s < 32) a.out[O_GCP + ((size_t)(slot * 32 + s) * 3 + j) * 3072 + c] = bf2f(QKV[((size_t)s * 2048 + 2045 + j) * 3072 + c]);
        else a.out[O_GCS + ((size_t)(slot * 16 + s - 32) * 3 + j) * 3072 + c] = bf2f(QKV[((size_t)NTP + (s - 32) * 32 + 29 + j) * 3072 + c]);
    }

    const int gw = wave * gridDim.x + bidx(), NGW = gridDim.x * 8;
#pragma unroll 1
    for (int item = gw; item < 8320; item += NGW) {
        const bool samp = item >= 8192;
        int b, h, t0, R; size_t row0;
        if (!samp) { const int sc = item >> 3; h = item & 7; b = sc >> 5; t0 = (sc & 31) * 64; row0 = (size_t)b * 2048; R = 64; }
        else { const int it = item - 8192; b = it >> 3; h = it & 7; t0 = 0; row0 = (size_t)NTP + b * 32; R = 32; }
        const float* hist = a.in[4] + (size_t)(slot * 16 + b) * 3 * 3072;
        {
            G1_LANEVARS
            float g = 0.f, be = 0.f;
            if (lane < R) {
                const float av = AB[(row0 + t0 + lane) * 16 + h] + a.in[19][slot * 8 + h], bv = AB[(row0 + t0 + lane) * 16 + 8 + h];
                const float sp = av > 20.f ? av : log1pf(__expf(av));
                g = -__expf(a.in[18][slot * 8 + h]) * sp; be = sigmoidf_(bv);
            }
            float x = g;
#pragma unroll
            for (int o = 1; o < 64; o <<= 1) { const float y = __shfl_up(x, o); if (lane >= o) x += y; }
            GCs[lane] = x; BEs[lane] = be;
            GB[(size_t)item * 128 + lane] = x; GB[(size_t)item * 128 + 64 + lane] = be;
        }
        {
            G1_LANEVARS
            const int sub = lane & 7, il = lane >> 3; const int Tlen = samp ? 32 : 2048;
            auto load_raw = [&](int part, u32x4 (&rg)[17]) {
#pragma unroll
                for (int n = 0; n < 17; ++n) {
                    const int idx = lane + 64 * n, row = idx >> 4, ch = idx & 15, tt = t0 - 3 + row;
                    rg[n] = (u32x4){0u, 0u, 0u, 0u};
                    if (idx < 1072 && tt < Tlen) {
                        if (tt >= 0) rg[n] = *(const u32x4*)(QKV + (row0 + tt) * 3072 + part * 1024 + h * 128 + ch * 8);
                        else if (samp) { const float* p = hist + (size_t)(3 + tt) * 3072 + part * 1024 + h * 128 + ch * 8; const f32x4 v0 = *(const f32x4*)p, v1 = *(const f32x4*)(p + 4);
                            rg[n] = (u32x4){pk2(v0.x, v0.y), pk2(v0.z, v0.w), pk2(v1.x, v1.y), pk2(v1.z, v1.w)}; }
                    }
                }
            };
            auto store_raw = [&](const u32x4 (&rg)[17]) {
#pragma unroll
                for (int n = 0; n < 17; ++n) { const int idx = lane + 64 * n, row = idx >> 4, ch = idx & 15; if (idx < 1072) *(LAS u32x4*)(Ks + row * 136 + ch * 8) = rg[n]; }
            };
            u32x4 rq[17], rk[17];
            load_raw(0, rq);
            store_raw(rq);
            asm volatile("s_waitcnt lgkmcnt(0)" ::: "memory");
            load_raw(1, rk);
#pragma unroll 1
            for (int part = 0; part < 2; ++part) {
                const int col0 = part * 1024 + h * 128 + sub * 16;
                f32x2 cw[4][8];
#pragma unroll
                for (int j = 0; j < 4; ++j)
#pragma unroll
                    for (int e = 0; e < 16; e += 4) { const f32x4 wv = *(const f32x4*)(convw + j * 3072 + col0 + e); cw[j][e / 2] = (f32x2){wv.x, wv.y}; cw[j][e / 2 + 1] = (f32x2){wv.z, wv.w}; }
                if (part == 1) { asm volatile("s_waitcnt lgkmcnt(0)" ::: "memory"); store_raw(rk); asm volatile("s_waitcnt lgkmcnt(0)" ::: "memory"); }
#pragma unroll 1
                for (int tg = 0; tg < 8; ++tg) {
                    const int i = tg * 8 + il; const bool valid = i < R;
                    f32x2 y[8];
#pragma unroll
                    for (int k = 0; k < 8; ++k) y[k] = (f32x2){0.f, 0.f};
#pragma unroll
                    for (int j = 0; j < 4; ++j) { const LAS bf16_t* rp = Ks + (i + j) * 136 + sub * 16;
                        const u32x4 xa = *(const LAS u32x4*)rp, xb = *(const LAS u32x4*)(rp + 8);
                        const unsigned xw[8] = {xa.x, xa.y, xa.z, xa.w, xb.x, xb.y, xb.z, xb.w};
#pragma unroll
                        for (int k = 0; k < 8; ++k) { const f32x2 xv = (f32x2){__uint_as_float(xw[k] << 16), __uint_as_float(xw[k] & 0xFFFF0000u)}; y[k] = cw[j][k] * xv + y[k]; } }
                    f32x2 ss2 = (f32x2){0.f, 0.f};
#pragma unroll
                    for (int k = 0; k < 8; ++k) {
                        const f32x2 t = y[k] * (-1.4426950408889634f);
                        f32x2 d = (f32x2){__builtin_amdgcn_exp2f(t.x), __builtin_amdgcn_exp2f(t.y)} + 1.0f;
                        d = (f32x2){__builtin_amdgcn_rcpf(d.x), __builtin_amdgcn_rcpf(d.y)};
                        y[k] = valid ? y[k] * d : (f32x2){0.f, 0.f};
                        ss2 = y[k] * y[k] + ss2;
                    }
                    float ss = ss2.x + ss2.y;
                    ss += __shfl_xor(ss, 1); ss += __shfl_xor(ss, 2); ss += __shfl_xor(ss, 4);
                    const float rn = rsqrtf(ss + EPS) * (part == 0 ? 0.08838834764831845f : 1.f);
                    u32x4 p0, p1;
                    { unsigned pw[8];
#pragma unroll
                      for (int k = 0; k < 8; ++k) { const f32x2 z = y[k] * rn; pw[k] = pk2(z.x, z.y); }
                      p0 = (u32x4){pw[0], pw[1], pw[2], pw[3]}; p1 = (u32x4){pw[4], pw[5], pw[6], pw[7]}; }
                    const size_t go = (row0 + t0 + i) * 1024 + h * 128 + sub * 16;
                    if (part == 0) { if (valid) { *(u32x4*)(Hq + go) = p0; *(u32x4*)(Hq + go + 8) = p1; } }
                    else { asm volatile("s_waitcnt lgkmcnt(0)" ::: "memory");
                           *(LAS u32x4*)(Ks + i * 136 + sub * 16) = p0; *(LAS u32x4*)(Ks + i * 136 + sub * 16 + 8) = p1;
                           if (valid) { *(u32x4*)(KN + go) = p0; *(u32x4*)(KN + go + 8) = p1; } }
                }
            }
        }
        {
            G1_LANEVARS
            f32x4 kk[10];
#pragma unroll
            for (int rb = 0; rb < 4; ++rb)
#pragma unroll
                for (int cb = 0; cb <= rb; ++cb) kk[rb * (rb + 1) / 2 + cb] = mm16(Ks + rb * 16 * 136, 136, Ks + cb * 16 * 136, 136, 128, (f32x4){0.f, 0.f, 0.f, 0.f}, lane);
            asm volatile("s_waitcnt lgkmcnt(0)" ::: "memory");
#pragma unroll
            for (int rb = 0; rb < 4; ++rb)
#pragma unroll
                for (int cb = 0; cb <= rb; ++cb) {
                    const int j = cb * 16 + r; const float gj = GCs[j];
#pragma unroll
                    for (int jj = 0; jj < 4; ++jj) { const int i = rb * 16 + quad * 4 + jj;
                        AT[i * 65 + j] = (i > j) ? BEs[i] * kk[rb * (rb + 1) / 2 + cb][jj] * __expf(GCs[i] - gj) : 0.f; }
                }
            asm volatile("s_waitcnt lgkmcnt(0)" ::: "memory");
        }
        {
            G1_LANEVARS
            const int base = quad * 16, cc = r;
            for (int i = 1; i < 16; ++i) {
                float tacc = 0.f;
                for (int j = 0; j < i; ++j) {
                    const float aij = AT[(base + i) * 65 + base + j];
                    const float tj = (j > cc) ? AT[(base + j) * 65 + base + cc] : (j == cc ? 1.f : 0.f);
                    tacc -= aij * tj;
                }
                asm volatile("s_waitcnt lgkmcnt(0)" ::: "memory");
                if (cc < i) AT[(base + i) * 65 + base + cc] = tacc;
                asm volatile("s_waitcnt lgkmcnt(0)" ::: "memory");
            }
#pragma unroll 1
            for (int lev = 1; lev < 4; ++lev)
#pragma unroll 1
                for (int bb = 0; bb < 4 - lev; ++bb) {
                    const int aa = bb + lev, q4 = quad * 4;
                    float mv[4] = {0.f, 0.f, 0.f, 0.f};
                    for (int cb = bb; cb < aa; ++cb) {
                        for (int k = 0; k < 16; ++k) {
                            float tk;
                            if (cb == bb) tk = (cc < k) ? AT[(bb * 16 + k) * 65 + bb * 16 + cc] : (cc == k ? 1.f : 0.f);
                            else tk = AT[(bb * 16 + k) * 65 + cb * 16 + cc];
#pragma unroll
                            for (int jj = 0; jj < 4; ++jj) mv[jj] += AT[(aa * 16 + q4 + jj) * 65 + cb * 16 + k] * tk;
                        }
                    }
                    asm volatile("s_waitcnt lgkmcnt(0)" ::: "memory");
#pragma unroll
                    for (int jj = 0; jj < 4; ++jj) AT[(bb * 16 + q4 + jj) * 65 + aa * 16 + cc] = mv[jj];
                    asm volatile("s_waitcnt lgkmcnt(0)" ::: "memory");
                    float tv[4] = {mv[0], mv[1], mv[2], mv[3]};
                    for (int k = 0; k < 16; ++k) {
                        const float mk = AT[(bb * 16 + k) * 65 + aa * 16 + cc];
#pragma unroll
                        for (int jj = 0; jj < 4; ++jj) { const int ii = q4 + jj; const float dv = AT[(aa * 16 + ii) * 65 + aa * 16 + k]; if (k < ii) tv[jj] += dv * mk; }
                    }
                    asm volatile("s_waitcnt lgkmcnt(0)" ::: "memory");
#pragma unroll
                    for (int jj = 0; jj < 4; ++jj) AT[(bb * 16 + q4 + jj) * 65 + aa * 16 + cc] = -tv[jj];
                    asm volatile("s_waitcnt lgkmcnt(0)" ::: "memory");
                }
        }
        {
            G1_LANEVARS
            const int i = lane, ba = i >> 4;
#pragma unroll 1
            for (int c8 = 0; c8 < 8; ++c8) {
                const int bc = c8 >> 1; float tv[8];
#pragma unroll
                for (int k = 0; k < 8; ++k) { const int cc = c8 * 8 + k;
                    tv[k] = ba == bc ? (cc < i ? AT[i * 65 + cc] : (cc == i ? 1.f : 0.f)) : (ba > bc ? AT[(bc * 16 + (i & 15)) * 65 + ba * 16 + (cc & 15)] : 0.f); }
                *(u32x4*)(TB + (size_t)item * 4096 + i * 64 + c8 * 8) = pack8(tv);
            }
        }
        asm volatile("s_waitcnt lgkmcnt(0)" ::: "memory");
    }
}

__device__ __forceinline__ void gdn_phase(const Args& a, LAS unsigned char* lds, int slot) {
    constexpr int QS_O = 0, KS_O = 17408, KTS_O = 34816, VS_O = 53248, STS_O = 71680, TS_O = 106496, QKS_O = 115712, PTS_O = 124928, GT_O = 143360, CW_O = 145408;
    LAS bf16_t* Qs = (LAS bf16_t*)(lds + QS_O);
    LAS bf16_t* Ks = (LAS bf16_t*)(lds + KS_O);
    LAS bf16_t* KTs = (LAS bf16_t*)(lds + KTS_O);
    LAS bf16_t* Vs = (LAS bf16_t*)(lds + VS_O);
    LAS bf16_t* UGs = (LAS bf16_t*)(lds + VS_O);
    LAS bf16_t* STs = (LAS bf16_t*)(lds + STS_O);
    LAS bf16_t* Ts = (LAS bf16_t*)(lds + TS_O);
    LAS bf16_t* QKs = (LAS bf16_t*)(lds + QKS_O);
    LAS bf16_t* PTs = (LAS bf16_t*)(lds + PTS_O);
    LAS bf16_t* UTs = PTs;
    LAS float* Os = (LAS float*)(lds + QS_O);
    LAS float* GC = (LAS float*)(lds + GT_O);
    LAS float* BETA = GC + 64;
    LAS float* CW = (LAS float*)(lds + CW_O);

    const int tid0 = tidx();
#define GDN_LANEVARS int tid = tid0; OPAQUE_V(tid); const int lane = tid & 63, w = __builtin_amdgcn_readfirstlane(tid >> 6), r = lane & 15, quad = lane >> 4; (void)lane; (void)w; (void)r; (void)quad;
    const bf16_t* QKV = (const bf16_t*)(a.ws + BG_QKV); const bf16_t* Z = (const bf16_t*)(a.ws + BG_Z);
    const bf16_t* KN = (const bf16_t*)(a.ws + BG_KN); const bf16_t* TB = (const bf16_t*)(a.ws + BG_TB); const float* GB = (const float*)(a.ws + BG_GB);
    bf16_t* Hb = (bf16_t*)(a.ws + WS_H);
    const float* convw = a.in[17] + (size_t)slot * 4 * 3072;
    const float* onorm = a.in[20] + slot * 128;

#pragma unroll 1
    for (int item = bidx(); item < 256 + 128; item += gridDim.x) {
        const bool samp = item >= 256;
        const int it = samp ? item - 256 : item, b = it >> 3, h = it & 7;
        const int nch = samp ? 1 : 32, R = samp ? 32 : 64;
        const size_t row0 = samp ? (size_t)NTP + b * 32 : (size_t)b * 2048;
        const float* hist = a.in[4] + (size_t)(slot * 16 + b) * 3 * 3072;
        const int ci0 = samp ? 8192 + b * 8 + h : (b * 32) * 8 + h;
        f32x4 S[8];
        __syncthreads();
        { GDN_LANEVARS
        if (samp) {
            const float* s0 = a.in[5] + ((size_t)(slot * 16 + b) * 8 + h) * 16384;
#pragma unroll
            for (int dt = 0; dt < 8; ++dt)
#pragma unroll
                for (int jj = 0; jj < 4; ++jj) { S[dt][jj] = s0[(dt * 16 + quad * 4 + jj) * 128 + w * 16 + r]; __builtin_amdgcn_sched_barrier(0); }
        } else {
#pragma unroll
            for (int dt = 0; dt < 8; ++dt) S[dt] = (f32x4){0.f, 0.f, 0.f, 0.f};
        }
#pragma unroll
        for (int dt = 0; dt < 8; ++dt) { u32x2 o; o.x = pk2(S[dt][0], S[dt][1]); o.y = pk2(S[dt][2], S[dt][3]); *(LAS u32x2*)(STs + (w * 16 + r) * 136 + dt * 16 + quad * 4) = o; }
        CW[tid] = convw[(tid >> 7) * 3072 + 2048 + h * 128 + (tid & 127)];
        }
        u32x4 pq0, pq1, pk0, pk1, pz0, pz1, pt, pv[8]; float pg = 0.f;
        u32x4 zc0 = (u32x4){0u, 0u, 0u, 0u}, zc1 = zc0;
        auto fetch = [&](int c) {
            int tid = tid0; OPAQUE_V(tid);
            const int i = tid >> 3, sub = tid & 7; const bool valid = i < R;
            const size_t go = (row0 + c * 64 + i) * 1024 + h * 128 + sub * 16;
            const u32x4 zz = (u32x4){0u, 0u, 0u, 0u};
            pq0 = zz; pq1 = zz; pk0 = zz; pk1 = zz; pz0 = zz; pz1 = zz;
            if (valid) { pq0 = *(const u32x4*)(Hb + go); pq1 = *(const u32x4*)(Hb + go + 8); pk0 = *(const u32x4*)(KN + go); pk1 = *(const u32x4*)(KN + go + 8);
                         pz0 = *(const u32x4*)(Z + go); pz1 = *(const u32x4*)(Z + go + 8); }
            const int col0 = 2048 + h * 128 + sub * 16;
#pragma unroll
            for (int j = 0; j < 4; ++j) {
                const int tt = c * 64 + i - 3 + j;
                pv[2 * j] = zz; pv[2 * j + 1] = zz;
                if (valid) {
                    if (tt >= 0) { const bf16_t* p = QKV + (row0 + tt) * 3072 + col0; pv[2 * j] = *(const u32x4*)p; pv[2 * j + 1] = *(const u32x4*)(p + 8); }
                    else if (samp) { const float* p = hist + (size_t)(3 + tt) * 3072 + col0; float x[16];
#pragma unroll
                        for (int e = 0; e < 16; e += 4) { const f32x4 v = *(const f32x4*)(p + e); x[e] = v.x; x[e + 1] = v.y; x[e + 2] = v.z; x[e + 3] = v.w; }
                        pv[2 * j] = pack8(x); pv[2 * j + 1] = pack8(x + 8); }
                }
            }
            pt = *(const u32x4*)(TB + (size_t)(ci0 + 8 * c) * 4096 + tid * 8);
            if (tid < 128) pg = GB[(size_t)(ci0 + 8 * c) * 128 + tid];
        };
        fetch(0);
        __syncthreads();
#pragma unroll 1
        for (int c = 0; c < nch; ++c) {
            {
                GDN_LANEVARS
                const int i = tid >> 3, sub = tid & 7;
                *(LAS u32x4*)(Qs + i * 136 + sub * 16) = pq0; *(LAS u32x4*)(Qs + i * 136 + sub * 16 + 8) = pq1;
                *(LAS u32x4*)(Ks + i * 136 + sub * 16) = pk0; *(LAS u32x4*)(Ks + i * 136 + sub * 16 + 8) = pk1;
                { const unsigned kw[8] = {pk0.x, pk0.y, pk0.z, pk0.w, pk1.x, pk1.y, pk1.z, pk1.w};
#pragma unroll
                  for (int e = 0; e < 8; ++e) { KTs[(sub * 16 + 2 * e) * 72 + i] = (bf16_t)(kw[e] & 0xFFFFu); KTs[(sub * 16 + 2 * e + 1) * 72 + i] = (bf16_t)(kw[e] >> 16); } }
                float y[16];
#pragma unroll
                for (int e = 0; e < 16; ++e) y[e] = 0.f;
#pragma unroll
                for (int j = 0; j < 4; ++j) { float x[16]; unpack8(pv[2 * j], x); unpack8(pv[2 * j + 1], x + 8);
#pragma unroll
                    for (int e = 0; e < 16; e += 4) { const f32x4 wv = *(const LAS f32x4*)(CW + j * 128 + sub * 16 + e); y[e] += wv.x * x[e]; y[e + 1] += wv.y * x[e + 1]; y[e + 2] += wv.z * x[e + 2]; y[e + 3] += wv.w * x[e + 3]; } }
                if (i < R) {
#pragma unroll
                    for (int e = 0; e < 16; ++e) y[e] = siluf(y[e]);
                } else {
#pragma unroll
                    for (int e = 0; e < 16; ++e) y[e] = 0.f;
                }
                *(LAS u32x4*)(Vs + i * 136 + sub * 16) = pack8(y); *(LAS u32x4*)(Vs + i * 136 + sub * 16 + 8) = pack8(y + 8);
                *(LAS u32x4*)(Ts + i * 72 + sub * 8) = pt;
                if (tid < 128) GC[tid] = pg;
                zc0 = pz0; zc1 = pz1;
            }
            __syncthreads();
            if (c + 1 < nch) fetch(c + 1);
            bf16x8 sfr[4];
            {
                GDN_LANEVARS
                bf16x8 qa[4]; ldfrag<4>(Qs + (w >> 1) * 16 * 136, 136, qa, lane);
#pragma unroll
                for (int t2 = 0; t2 < 2; ++t2) {
                    const int tl = w * 2 + t2, rb = tl >> 2, cb = tl & 3;
                    f32x4 acc = (f32x4){0.f, 0.f, 0.f, 0.f};
                    if (cb <= rb) acc = mm16a<4>(qa, Ks + cb * 16 * 136, 136, acc, lane);
                    const int j = cb * 16 + r; const float gj = GC[j];
#pragma unroll
                    for (int jj = 0; jj < 4; ++jj) { const int i = rb * 16 + quad * 4 + jj;
                        QKs[i * 72 + j] = f2bf((i >= j && cb <= rb) ? acc[jj] * __expf(GC[i] - gj) : 0.f); }
                }
                ldfrag<4>(STs + w * 16 * 136, 136, sfr, lane);
#pragma unroll
                for (int rt = 0; rt < 4; ++rt) {
                    f32x4 acc = (f32x4){0.f, 0.f, 0.f, 0.f};
                    acc = mm16b<4>(Ks + rt * 16 * 136, 136, sfr, acc, lane);
                    const int e = w * 16 + r; float p[4];
#pragma unroll
                    for (int jj = 0; jj < 4; ++jj) { const int j = rt * 16 + quad * 4 + jj; p[jj] = BETA[j] * (bf2f(Vs[j * 136 + e]) - __expf(GC[j]) * acc[jj]); }
                    u32x2 o; o.x = pk2(p[0], p[1]); o.y = pk2(p[2], p[3]);
                    *(LAS u32x2*)(PTs + e * 72 + rt * 16 + quad * 4) = o;
                }
            }
            __syncthreads();
            f32x4 o[4];
            {
                GDN_LANEVARS
                f32x4 u[4];
                { bf16x8 pfr[2]; ldfrag<2>(PTs + w * 16 * 72, 72, pfr, lane);
#pragma unroll
                for (int rt = 0; rt < 4; ++rt) u[rt] = mm16b<2>(Ts + rt * 16 * 72, 72, pfr, (f32x4){0.f, 0.f, 0.f, 0.f}, lane); }
                asm volatile("s_waitcnt lgkmcnt(0)" ::: "memory");
                const int e = w * 16 + r; const float gl = GC[63];
#pragma unroll
                for (int rt = 0; rt < 4; ++rt) {
                    const int i0 = rt * 16 + quad * 4;
                    u32x2 o1; o1.x = pk2(u[rt][0], u[rt][1]); o1.y = pk2(u[rt][2], u[rt][3]);
                    *(LAS u32x2*)(UTs + e * 72 + i0) = o1;
                    u32x2 o2; o2.x = pk2(u[rt][0] * __expf(gl - GC[i0]), u[rt][1] * __expf(gl - GC[i0 + 1])); o2.y = pk2(u[rt][2] * __expf(gl - GC[i0 + 2]), u[rt][3] * __expf(gl - GC[i0 + 3]));
                    *(LAS u32x2*)(UGs + e * 72 + i0) = o2;
                }
                asm volatile("s_waitcnt lgkmcnt(0)" ::: "memory");
                bf16x8 ufr[2]; ldfrag<2>(UTs + w * 16 * 72, 72, ufr, lane);
#pragma unroll
                for (int rt = 0; rt < 4; ++rt) {
                    const f32x4 a1 = mm16b<4>(Qs + rt * 16 * 136, 136, sfr, (f32x4){0.f, 0.f, 0.f, 0.f}, lane);
                    const f32x4 a2 = mm16b<2>(QKs + rt * 16 * 72, 72, ufr, (f32x4){0.f, 0.f, 0.f, 0.f}, lane);
#pragma unroll
                    for (int jj = 0; jj < 4; ++jj) o[rt][jj] = __expf(GC[rt * 16 + quad * 4 + jj]) * a1[jj] + a2[jj];
                }
                const float egl = __expf(gl);
                { bf16x8 gfr[2]; ldfrag<2>(UGs + w * 16 * 72, 72, gfr, lane);
#pragma unroll
                for (int dt = 0; dt < 8; ++dt) S[dt] = mm16b<2>(KTs + dt * 16 * 72, 72, gfr, S[dt] * egl, lane); }
                asm volatile("s_waitcnt lgkmcnt(0)" ::: "memory");
#pragma unroll
                for (int dt = 0; dt < 8; ++dt) { u32x2 ov; ov.x = pk2(S[dt][0], S[dt][1]); ov.y = pk2(S[dt][2], S[dt][3]); *(LAS u32x2*)(STs + (w * 16 + r) * 136 + dt * 16 + quad * 4) = ov; }
            }
            __syncthreads();
            { GDN_LANEVARS
#pragma unroll
            for (int rt = 0; rt < 4; ++rt)
#pragma unroll
                for (int jj = 0; jj < 4; ++jj) Os[(rt * 16 + quad * 4 + jj) * 129 + w * 16 + r] = o[rt][jj];
            }
            __syncthreads();
            {
                GDN_LANEVARS
                const int i = tid >> 3, sub = tid & 7, t = c * 64 + i;
                float v[16]; float ss = 0.f;
#pragma unroll
                for (int k = 0; k < 16; ++k) { v[k] = Os[i * 129 + sub * 16 + k]; ss += v[k] * v[k]; }
                ss += __shfl_xor(ss, 1); ss += __shfl_xor(ss, 2); ss += __shfl_xor(ss, 4);
                const float rn = rsqrtf(ss * (1.f / 128.f) + EPS);
                if (i < R) {
                    const size_t off = (row0 + t) * 1024 + h * 128 + sub * 16;
                    float z[16]; unpack8(zc0, z); unpack8(zc1, z + 8);
#pragma unroll
                    for (int k = 0; k < 16; ++k) v[k] = v[k] * rn * onorm[sub * 16 + k] * siluf(z[k]);
                    *(u32x4*)(Hb + off) = pack8(v); *(u32x4*)(Hb + off + 8) = pack8(v + 8);
                }
            }
            __syncthreads();
        }
        GDN_LANEVARS
        float* so = a.out + (samp ? O_GSS + ((size_t)(slot * 16 + b) * 8 + h) * 16384 : O_GSP + ((size_t)(slot * 32 + b) * 8 + h) * 16384);
#pragma unroll
        for (int dt = 0; dt < 8; ++dt)
#pragma unroll
            for (int jj = 0; jj < 4; ++jj) { so[(dt * 16 + quad * 4 + jj) * 128 + w * 16 + r] = S[dt][jj]; __builtin_amdgcn_sched_barrier(0); }
    }
}

__device__ __forceinline__ void mla_prep_phase(const Args& a) {
    const int lane = tidx() & 63, gw = bidx() * 8 + (tidx() >> 6), NGW = gridDim.x * 8;
    const bf16_t* PROJ = (const bf16_t*)(a.ws + BM_PROJ);
    bf16_t* CQ = (bf16_t*)(a.ws + BM_CQ); bf16_t* CKV = (bf16_t*)(a.ws + BM_CKV); bf16_t* KR = (bf16_t*)(a.ws + BM_KR);
    const f32x2* rope = (const f32x2*)(a.ws + WS_ROPE);
    float gq[6];
#pragma unroll
    for (int j = 0; j < 6; ++j) gq[j] = a.in[23][lane + 64 * j];
    const f32x4 gk = *(const f32x4*)(a.in[24] + 4 * lane);
#pragma unroll 1
    for (int row0 = gw * 4; row0 < MT; row0 += NGW * 4) {
        const bool samp = row0 >= NTP;
        bf16_t qh[4][6]; u32x2 kvh[4]; bf16_t x1h[4], x2h[4]; f32x2 cs[4];
#pragma unroll
        for (int rr = 0; rr < 4; ++rr) {
            const bf16_t* p = PROJ + (size_t)(row0 + rr) * 768;
#pragma unroll
            for (int j = 0; j < 6; ++j) qh[rr][j] = p[lane + 64 * j];
            kvh[rr] = *(const u32x2*)(p + 384 + 4 * lane);
            const int row = row0 + rr, pos = samp ? 1024 + ((row - NTP) & 31) : (row & 2047);
            x1h[rr] = p[640 + (lane & 15)]; x2h[rr] = p[656 + (lane & 15)]; cs[rr] = rope[pos * 16 + (lane & 15)];
        }
#pragma unroll
        for (int rr = 0; rr < 4; ++rr) {
            const int row = row0 + rr;
            const size_t krow = samp ? (size_t)NTP + (size_t)((row - NTP) >> 5) * 1056 + 1024 + ((row - NTP) & 31) : (size_t)row;
            float q[6]; float ss = 0.f;
#pragma unroll
            for (int j = 0; j < 6; ++j) { q[j] = bf2f(qh[rr][j]); ss += q[j] * q[j]; }
#pragma unroll
            for (int o = 1; o < 64; o <<= 1) ss += __shfl_xor(ss, o);
            float rn = rsqrtf(ss * (1.f / 384.f) + EPS);
#pragma unroll
            for (int j = 0; j < 6; ++j) CQ[(size_t)row * 384 + lane + 64 * j] = f2bf(q[j] * rn * gq[j]);
            const f32x4 kv = bf4(kvh[rr]);
            ss = kv.x * kv.x + kv.y * kv.y + kv.z * kv.z + kv.w * kv.w;
#pragma unroll
            for (int o = 1; o < 64; o <<= 1) ss += __shfl_xor(ss, o);
            rn = rsqrtf(ss * (1.f / 256.f) + EPS);
            const f32x4 kvn = kv * rn * gk;
            float* lo = samp ? a.out + O_MLS + (size_t)(row - NTP) * 256 : a.out + O_MLP + (size_t)row * 256;
            *(f32x4*)(lo + 4 * lane) = kvn;
            { u32x2 o; o.x = pk2(kvn.x, kvn.y); o.y = pk2(kvn.z, kvn.w); *(u32x2*)(CKV + krow * 256 + 4 * lane) = o; }
            if (lane < 16) {
                const float x1 = bf2f(x1h[rr]), x2 = bf2f(x2h[rr]);
                const float r1 = x1 * cs[rr].x - x2 * cs[rr].y, r2 = x1 * cs[rr].y + x2 * cs[rr].x;
                float* ko = samp ? a.out + O_MKS + (size_t)(row - NTP) * 32 : a.out + O_MKP + (size_t)row * 32;
                ko[lane] = r1; ko[lane + 16] = r2;
                KR[krow * 32 + lane] = f2bf(r1); KR[krow * 32 + 16 + lane] = f2bf(r2);
            }
        }
    }
    const size_t gt = (size_t)bidx() * NTHREADS + tidx(), NGT = (size_t)gridDim.x * NTHREADS;
    for (size_t i0 = gt; i0 < 16ull * 1024 * 64; i0 += 4 * NGT) {
        f32x4 v[4];
#pragma unroll
        for (int u = 0; u < 4; ++u) { const size_t i = i0 + u * NGT; if (i < 16ull * 1024 * 64) v[u] = *(const f32x4*)(a.in[6] + (i >> 6) * 256 + (int)(i & 63) * 4); }
#pragma unroll
        for (int u = 0; u < 4; ++u) { const size_t i = i0 + u * NGT; if (i < 16ull * 1024 * 64) {
            const size_t bk = i >> 6; const int c4 = (int)(i & 63) * 4; const size_t b = bk >> 10, kk = bk & 1023;
            u32x2 o; o.x = pk2(v[u].x, v[u].y); o.y = pk2(v[u].z, v[u].w);
            *(u32x2*)(CKV + ((size_t)NTP + b * 1056 + kk) * 256 + c4) = o; } }
    }
    for (size_t i = gt; i < 16ull * 1024 * 8; i += NGT) {
        const size_t bk = i >> 3; const int c4 = (int)(i & 7) * 4; const size_t b = bk >> 10, kk = bk & 1023;
        const f32x4 v = *(const f32x4*)(a.in[7] + bk * 32 + c4);
        u32x2 o; o.x = pk2(v.x, v.y); o.y = pk2(v.z, v.w);
        *(u32x2*)(KR + ((size_t)NTP + b * 1056 + kk) * 32 + c4) = o;
    }
}

template <bool MLA>
__device__ __forceinline__ void attn_phase(const Args& a, LAS unsigned char* lds) {
    constexpr int DQ = MLA ? 96 : 64, QST = DQ + 8, NKS = DQ / 32;
    LAS bf16_t* Qs = (LAS bf16_t*)lds;
    LAS bf16_t* KsB = Qs + 256 * QST;
    constexpr int KVB = 64 * QST + 64 * 68;
    const int tid = tidx(), lane = tid & 63, w = __builtin_amdgcn_readfirstlane(tid >> 6), r = lane & 15, quad = lane >> 4;
    bf16_t* Ob = (bf16_t*)(a.ws + WS_H);
    const bf16_t* Qg = (const bf16_t*)(a.ws + (MLA ? BM_Q : BS_PROJ));
    const bf16_t* KVg = (const bf16_t*)(a.ws + BM_KV); const bf16_t* KRg = (const bf16_t*)(a.ws + BM_KR);
    const bf16_t* SP = (const bf16_t*)(a.ws + BS_PROJ);
    const bf16_t* KC = (const bf16_t*)(a.ws + WS_SWAKC); const bf16_t* VC = (const bf16_t*)(a.ws + WS_SWAVC);
    const f32x2* rope = (const f32x2*)(a.ws + WS_ROPE);
    const float* biasT = (const float*)(a.ws + WS_BIAS);
    const int NP = 4096, NITEM = NP + (MLA ? 256 : 64);
    const float scale = (MLA ? 0.10206207261596575f : 0.125f) * 1.4426950408889634f;

#pragma unroll 1
    for (int item = bidx(); item < NITEM; item += gridDim.x) {
        const bool samp = item >= NP;
        int b, h = 0, kvh = 0, cch = 0, p4 = 0;
        size_t qrow0, krow0 = 0; int kt0 = 0, kt1, nq;
        if (MLA) {
            if (!samp) { p4 = 7 - (item >> 9); const int bh = item & 511; b = bh >> 4; h = bh & 15; qrow0 = (size_t)b * 2048 + p4 * 256; krow0 = (size_t)b * 2048; kt1 = 4 * p4 + 4; nq = 256; }
            else { const int it = item - NP; b = it >> 4; h = it & 15; qrow0 = (size_t)NTP + b * 32; krow0 = (size_t)NTP + (size_t)b * 1056; kt1 = 17; nq = 32; }
        } else {
            if (!samp) { b = item >> 7; cch = (item >> 2) & 31; kvh = item & 3; qrow0 = (size_t)b * 2048 + cch * 64; kt0 = cch >= 2 ? 0 : 2 - cch; kt1 = 3; nq = 256; }
            else { const int it = item - NP; b = it >> 2; kvh = it & 3; qrow0 = (size_t)NTP + b * 32; kt1 = 3; nq = 128; }
        }
        int head, nkw, qi[2]; bool qvalid[2];
        if (MLA) { head = h; nkw = samp ? 1056 : (4 * p4 + (w >> 1) + 1) * 64;
#pragma unroll
            for (int g = 0; g < 2; ++g) { qi[g] = w * 32 + g * 16 + r; qvalid[g] = qi[g] < nq; } }
        else if (!samp) { head = kvh * 4 + (w >> 1); nkw = 192;
#pragma unroll
            for (int g = 0; g < 2; ++g) { qi[g] = (w & 1) * 32 + g * 16 + r; qvalid[g] = true; } }
        else { head = kvh * 4 + (w & 3); nkw = 160;
#pragma unroll
            for (int g = 0; g < 2; ++g) { qi[g] = g * 16 + r; qvalid[g] = w < 4; } }

        __syncthreads();
        if (MLA) {
            for (int idx = tid; idx < 256 * 8; idx += NTHREADS) { const int lr = idx >> 3, ch = idx & 7; const int rr = lr < nq ? lr : 0;
                *(LAS u32x4*)(Qs + lr * QST + ch * 8) = *(const u32x4*)(Qg + (qrow0 + rr) * 1536 + h * 96 + ch * 8); }
            { const int lr = tid >> 1, ch = tid & 1; const int rr = lr < nq ? lr : 0;
                const bf16_t* src = Qg + (qrow0 + rr) * 1536 + h * 96 + 64 + ch * 8;
                float x1[8], x2[8], o1[8], o2[8]; unpack8(*(const u32x4*)src, x1); unpack8(*(const u32x4*)(src + 16), x2);
                const int pos = (samp ? 1024 : p4 * 256) + rr;
                const f32x2* cs = rope + pos * 16 + ch * 8;
#pragma unroll
                for (int k = 0; k < 8; ++k) { const f32x2 c = cs[k]; o1[k] = x1[k] * c.x - x2[k] * c.y; o2[k] = x1[k] * c.y + x2[k] * c.x; }
                *(LAS u32x4*)(Qs + lr * QST + 64 + ch * 8) = pack8(o1); *(LAS u32x4*)(Qs + lr * QST + 80 + ch * 8) = pack8(o2); }
        } else {
            for (int idx = tid; idx < 256 * 8; idx += NTHREADS) { const int lr = idx >> 3, ch = idx & 7;
                int hd, qq;
                if (!samp) { hd = kvh * 4 + (lr >> 6); qq = lr & 63; } else if (lr < 128) { hd = kvh * 4 + (lr >> 5); qq = lr & 31; } else { hd = kvh * 4; qq = 0; }
                *(LAS u32x4*)(Qs + lr * QST + ch * 8) = *(const u32x4*)(Qg + (qrow0 + qq) * 1536 + hd * 64 + ch * 8); }
        }
        float m[2], lsum[2];
        f32x4 O[2][4];
#pragma unroll
        for (int g = 0; g < 2; ++g) {
            if (MLA) { m[g] = -1e30f; lsum[g] = 0.f; } else { m[g] = a.in[29][head] * 1.4426950408889634f; lsum[g] = quad == 0 ? 1.f : 0.f; }
#pragma unroll
            for (int et = 0; et < 4; ++et) O[g][et] = (f32x4){0.f, 0.f, 0.f, 0.f};
        }
        bf16x8 qf[2][NKS];
        u32x4 pk0 = (u32x4){0u, 0u, 0u, 0u}, pk1 = pk0, pv = pk0;
        auto fetch = [&](int kt) {
            pk0 = (u32x4){0u, 0u, 0u, 0u}; pk1 = pk0; pv = pk0;
            if (MLA) {
                { const int j = tid / 12, ch = tid % 12; const int kk = kt * 64 + j; const size_t kr = krow0 + kk;
                  if (!samp || kk < 1056) pk0 = ch < 8 ? *(const u32x4*)(KVg + kr * 2048 + h * 128 + ch * 8) : *(const u32x4*)(KRg + kr * 32 + (ch - 8) * 8); }
                if (tid < 256) { const int idx = tid + 512; const int j = idx / 12, ch = idx % 12; const int kk = kt * 64 + j; const size_t kr = krow0 + kk;
                  if (!samp || kk < 1056) pk1 = ch < 8 ? *(const u32x4*)(KVg + kr * 2048 + h * 128 + ch * 8) : *(const u32x4*)(KRg + kr * 32 + (ch - 8) * 8); }
                { const int j = tid >> 3, ec = tid & 7; const int kk = kt * 64 + j; const size_t kr = krow0 + kk;
                  if (!samp || kk < 1056) pv = *(const u32x4*)(KVg + kr * 2048 + h * 128 + 64 + ec * 8); }
            } else {
                const int j = tid >> 3, ch = tid & 7; const int kk = kt * 64 + j;
                if (!samp) { const size_t kr = (size_t)b * 2048 + (size_t)(cch - 2 + kt) * 64 + j;
                    pk0 = *(const u32x4*)(SP + kr * 1536 + 1024 + kvh * 64 + ch * 8); pv = *(const u32x4*)(SP + kr * 1536 + 1280 + kvh * 64 + ch * 8); }
                else if (kk < 128) { pk0 = *(const u32x4*)(KC + ((size_t)b * 128 + kk) * 256 + kvh * 64 + ch * 8); pv = *(const u32x4*)(VC + ((size_t)b * 128 + kk) * 256 + kvh * 64 + ch * 8); }
                else if (kk < 160) { const size_t kr = (size_t)NTP + b * 32 + (kk - 128);
                    pk0 = *(const u32x4*)(SP + kr * 1536 + 1024 + kvh * 64 + ch * 8); pv = *(const u32x4*)(SP + kr * 1536 + 1280 + kvh * 64 + ch * 8); }
            }
        };
        auto stash = [&](int par) {
            LAS bf16_t* Ks = KsB + par * KVB; LAS bf16_t* VTs = Ks + 64 * QST;
            if (MLA) {
                { const int j = tid / 12, ch = tid % 12; *(LAS u32x4*)(Ks + j * QST + ch * 8) = pk0; }
                if (tid < 256) { const int idx = tid + 512; const int j = idx / 12, ch = idx % 12; *(LAS u32x4*)(Ks + j * QST + ch * 8) = pk1; }
            } else { const int j = tid >> 3, ch = tid & 7; *(LAS u32x4*)(Ks + j * QST + ch * 8) = pk0; }
            { const int j = tid >> 3, ec = tid & 7; const unsigned vv[4] = {pv.x, pv.y, pv.z, pv.w};
#pragma unroll
              for (int k = 0; k < 4; ++k) { VTs[(ec * 8 + 2 * k) * 68 + j] = (bf16_t)(vv[k] & 0xFFFFu); VTs[(ec * 8 + 2 * k + 1) * 68 + j] = (bf16_t)(vv[k] >> 16); } }
        };
        fetch(kt0);
        stash(0);
        if (kt0 + 1 < kt1) fetch(kt0 + 1);
#pragma unroll 1
        for (int kt = kt0; kt < kt1; ++kt) {
            __syncthreads();
            if (kt + 1 < kt1) { stash((kt + 1 - kt0) & 1); if (kt + 2 < kt1) fetch(kt + 2); }
            const LAS bf16_t* Ks = KsB + ((kt - kt0) & 1) * KVB; const LAS bf16_t* VTs = Ks + 64 * QST;
            if (kt == kt0) {
#pragma unroll
                for (int g = 0; g < 2; ++g)
#pragma unroll
                    for (int ks = 0; ks < NKS; ++ks) qf[g][ks] = *(const LAS bf16x8*)(Qs + (w * 32 + g * 16 + r) * QST + ks * 32 + quad * 8);
            }
            if (kt * 64 >= nkw) continue;
            f32x4 s[2][4];
            __builtin_amdgcn_s_setprio(1);
#pragma unroll
            for (int sub = 0; sub < 4; ++sub) {
                f32x4 a0 = (f32x4){0.f, 0.f, 0.f, 0.f}, a1 = a0;
#pragma unroll
                for (int ks = 0; ks < NKS; ++ks) {
                    const bf16x8 kf = *(const LAS bf16x8*)(Ks + (sub * 16 + r) * QST + ks * 32 + quad * 8);
                    a0 = __builtin_amdgcn_mfma_f32_16x16x32_bf16(kf, qf[0][ks], a0, 0, 0, 0);
                    a1 = __builtin_amdgcn_mfma_f32_16x16x32_bf16(kf, qf[1][ks], a1, 0, 0, 0);
                }
                s[0][sub] = a0; s[1][sub] = a1;
            }
            __builtin_amdgcn_s_setprio(0);
            bf16x8 pf[2][2];
            const bool need_mask = kt * 64 + 64 > nkw;
#pragma unroll
            for (int g = 0; g < 2; ++g) {
                f32x4 sv[4];
#pragma unroll
                for (int sub = 0; sub < 4; ++sub) sv[sub] = s[g][sub] * scale;
                if (!MLA) {
#pragma unroll
                    for (int sub = 0; sub < 4; ++sub)
#pragma unroll
                        for (int jj = 0; jj < 4; ++jj) sv[sub][jj] += biasT[head * 256 + 191 + qi[g] - (kt * 64 + sub * 16 + quad * 4 + jj)];
                }
                if (need_mask) {
#pragma unroll
                    for (int sub = 0; sub < 4; ++sub)
#pragma unroll
                        for (int jj = 0; jj < 4; ++jj) if (kt * 64 + sub * 16 + quad * 4 + jj >= nkw) sv[sub][jj] = -INFINITY;
                }
                float mx = -INFINITY;
#pragma unroll
                for (int sub = 0; sub < 4; ++sub) mx = fmaxf(fmaxf(fmaxf(mx, sv[sub][0]), fmaxf(sv[sub][1], sv[sub][2])), sv[sub][3]);
                mx = fmaxf(mx, __shfl_xor(mx, 16)); mx = fmaxf(mx, __shfl_xor(mx, 32));
                const float mn = fmaxf(m[g], mx), alpha = __builtin_amdgcn_exp2f(m[g] - mn); m[g] = mn;
                f32x4 ps4 = (f32x4){0.f, 0.f, 0.f, 0.f};
#pragma unroll
                for (int sub = 0; sub < 4; ++sub) {
                    const f32x4 d = sv[sub] - mn;
                    const f32x4 pe = (f32x4){__builtin_amdgcn_exp2f(d[0]), __builtin_amdgcn_exp2f(d[1]), __builtin_amdgcn_exp2f(d[2]), __builtin_amdgcn_exp2f(d[3])};
                    s[g][sub] = pe; ps4 += pe;
                }
                lsum[g] = lsum[g] * alpha + ((ps4[0] + ps4[1]) + (ps4[2] + ps4[3]));
#pragma unroll
                for (int et = 0; et < 4; ++et) O[g][et] *= alpha;
#pragma unroll
                for (int s2 = 0; s2 < 2; ++s2) {
                    const unsigned a0 = pk2(s[g][2 * s2][0], s[g][2 * s2][1]), a1 = pk2(s[g][2 * s2][2], s[g][2 * s2][3]), a2 = pk2(s[g][2 * s2 + 1][0], s[g][2 * s2 + 1][1]), a3 = pk2(s[g][2 * s2 + 1][2], s[g][2 * s2 + 1][3]);
                    const u32x4 pu = (u32x4){a0, a1, a2, a3}; pf[g][s2] = *(const bf16x8*)&pu;
                }
            }
#pragma unroll
            for (int s2 = 0; s2 < 2; ++s2)
#pragma unroll
                for (int et = 0; et < 4; ++et) {
                    const LAS bf16_t* vp = VTs + (et * 16 + r) * 68 + s2 * 32 + quad * 4;
                    const u32x2 v0 = *(const LAS u32x2*)vp, v1 = *(const LAS u32x2*)(vp + 16);
                    const u32x4 vu = (u32x4){v0.x, v0.y, v1.x, v1.y};
                    O[0][et] = __builtin_amdgcn_mfma_f32_16x16x32_bf16(*(const bf16x8*)&vu, pf[0][s2], O[0][et], 0, 0, 0);
                    O[1][et] = __builtin_amdgcn_mfma_f32_16x16x32_bf16(*(const bf16x8*)&vu, pf[1][s2], O[1][et], 0, 0, 0);
                }
        }
#pragma unroll
        for (int g = 0; g < 2; ++g) {
            float l = lsum[g]; l += __shfl_xor(l, 16); l += __shfl_xor(l, 32);
            const float inv = 1.f / l;
            if (qvalid[g]) {
                bf16_t* op = Ob + (qrow0 + qi[g]) * 1024 + head * 64 + quad * 4;
#pragma unroll
                for (int et = 0; et < 4; ++et) { u32x2 o; o.x = pk2(O[g][et][0] * inv, O[g][et][1] * inv); o.y = pk2(O[g][et][2] * inv, O[g][et][3] * inv); *(u32x2*)(op + et * 16) = o; }
            }
        }
    }
}

__device__ __forceinline__ void swa_state_out(const Args& a) {
    const bf16_t* SP = (const bf16_t*)(a.ws + BS_PROJ);
    const size_t gt = (size_t)bidx() * NTHREADS + tidx(), NGT = (size_t)gridDim.x * NTHREADS;
    for (size_t i = gt; i < 32ull * 128 * 64; i += NGT) { const size_t b = i >> 13, j = (i >> 6) & 127; const int c = (int)(i & 63) * 4;
        const size_t row = b * 2048 + 1920 + j;
        const u32x2 k = *(const u32x2*)(SP + row * 1536 + 1024 + c), v = *(const u32x2*)(SP + row * 1536 + 1280 + c);
        *(f32x4*)(a.out + O_SKP + i * 4) = bf4(k); *(f32x4*)(a.out + O_SVP + i * 4) = bf4(v); }
    for (size_t i = gt; i < 16ull * 128 * 64; i += NGT) { const size_t b = i >> 13, j = (i >> 6) & 127; const int c = (int)(i & 63) * 4;
        if (j < 96) { *(f32x4*)(a.out + O_SKS + i * 4) = *(const f32x4*)(a.in[8] + (b * 128 + 32 + j) * 256 + c); *(f32x4*)(a.out + O_SVS + i * 4) = *(const f32x4*)(a.in[9] + (b * 128 + 32 + j) * 256 + c); }
        else { const size_t row = (size_t)NTP + b * 32 + (j - 96);
            *(f32x4*)(a.out + O_SKS + i * 4) = bf4(*(const u32x2*)(SP + row * 1536 + 1024 + c)); *(f32x4*)(a.out + O_SVS + i * 4) = bf4(*(const u32x2*)(SP + row * 1536 + 1280 + c)); } }
}

__device__ __forceinline__ void ffn_fix_phase(const Args& a, int layer) {
    bf16_t* U = (bf16_t*)(a.ws + BF_U); const float* GD = (const float*)(a.ws + BF_GD); const float* UD = (const float*)(a.ws + BF_UD);
    const float* cw = a.in[33] + (size_t)layer * 3 * DFF; const float* cb = a.in[34] + (size_t)layer * DFF;
    const size_t gt = (size_t)bidx() * NTHREADS + tidx(), NGT = (size_t)gridDim.x * NTHREADS;
    constexpr int CPR = DFF / 8, NG = MT / 32;
    auto fix_item = [&](size_t i, size_t& uoff) -> u32x4 {
        const int grp = (int)(i / (2 * CPR)), s = (int)((i / CPR) & 1), c0 = (int)(i % CPR) * 8;
        const int row = grp * 32 + s; const bool samp = row >= NTP; const bool first = samp || (grp & 63) == 0;
        const float* hp = a.in[10] + (size_t)(layer * 16 + (samp ? grp - NTP / 32 : 0)) * 2 * DFF + c0;
        const float* gc = GD + ((size_t)grp * 4 + 2 + s) * DFF + c0;
        const float* g1p = s == 1 ? GD + ((size_t)grp * 4 + 2) * DFF + c0 : (first ? hp + DFF : GD + ((size_t)(grp - 1) * 4 + 1) * DFF + c0);
        const float* g2p = s == 1 ? (first ? hp + DFF : GD + ((size_t)(grp - 1) * 4 + 1) * DFF + c0) : (first ? hp : GD + ((size_t)(grp - 1) * 4 + 0) * DFF + c0);
        const bool z1 = (s == 0) && first && !samp, z2 = first && !samp;
        const float* up = UD + ((size_t)grp * 2 + s) * DFF + c0;
        float o[8];
#pragma unroll
        for (int k = 0; k < 8; ++k) { const float g1 = z1 ? 0.f : g1p[k], g2 = z2 ? 0.f : g2p[k];
            const float y = cw[c0 + k] * g2 + cw[DFF + c0 + k] * g1 + cw[2 * DFF + c0 + k] * gc[k] + cb[c0 + k]; o[k] = siluf(y) * up[k]; }
        uoff = (size_t)row * DFF + c0;
        return pack8(o);
    };
    const size_t NIT = (size_t)NG * 2 * CPR;
    for (size_t i0 = gt; i0 < NIT; i0 += 2 * NGT) {
        const size_t i1 = i0 + NGT; size_t u0 = 0, u1 = 0;
        const u32x4 r0 = fix_item(i0, u0);
        u32x4 r1 = (u32x4){0u, 0u, 0u, 0u};
        if (i1 < NIT) r1 = fix_item(i1, u1);
        *(u32x4*)(U + u0) = r0;
        if (i1 < NIT) *(u32x4*)(U + u1) = r1;
    }
    for (size_t i = gt; i < 48ull * 2 * DFF; i += NGT) { const int sq = (int)(i / (2 * DFF)), j = (int)((i / DFF) & 1), c = (int)(i % DFF);
        const int grp = sq < 32 ? sq * 64 + 63 : NTP / 32 + (sq - 32);
        const float v = GD[((size_t)grp * 4 + j) * DFF + c];
        if (sq < 32) a.out[O_FCP + ((size_t)(layer * 32 + sq) * 2 + j) * DFF + c] = v; else a.out[O_FCS + ((size_t)(layer * 16 + sq - 32) * 2 + j) * DFF + c] = v; }
}

#define XB_TMO      128
#define XB_XCNT(j)  (256  + 64 * (j))
#define XB_XSUB(j)  (1280 + 64 * (j))
#define XB_XGEN(j)  (2304 + 64 * (j))
#define XB_TOP      3328
#define XB_TOPGEN   3392
#define XCD_BAR_WORDS 3456
#define XB_SPIN_CAP (1u << 18)
__device__ __forceinline__ unsigned xb_ld(unsigned* p)              { return __hip_atomic_load(p, __ATOMIC_RELAXED, __HIP_MEMORY_SCOPE_AGENT); }
__device__ __forceinline__ unsigned xb_add(unsigned* p, unsigned v) { return __hip_atomic_fetch_add(p, v, __ATOMIC_RELAXED, __HIP_MEMORY_SCOPE_AGENT); }
__device__ __forceinline__ unsigned xb_xcc_id() { return (unsigned)__builtin_amdgcn_s_getreg((3 << 11) | 20) & 0xFu; }
#define XB_SPIN(cond, bar) do { unsigned _sp = 0; while (cond) { __builtin_amdgcn_s_sleep(1); \
    if ((++_sp & 255u) == 0u) { if (xb_ld(&(bar)[XB_TMO])) break; if (_sp > XB_SPIN_CAP) { atomicAdd(&(bar)[XB_TMO], 1u); break; } } } } while (0)
struct XcdBarrier { unsigned* bar; unsigned x; volatile LAS unsigned* st; };
__device__ __forceinline__ XcdBarrier xcd_barrier_post(unsigned* bar, volatile LAS unsigned* st) {
    XcdBarrier b; b.bar = bar; b.x = xb_xcc_id(); b.st = st;
    if (threadIdx.x == 0) (void)xb_add(&bar[XB_XCNT(b.x)], 1u);
    return b;
}
__device__ __forceinline__ void xcd_barrier_complete(unsigned* bar, unsigned x, unsigned& nloc, unsigned& nx) {
    const unsigned G = gridDim.x * gridDim.y * gridDim.z;
    unsigned sum, cnt, mine, sp = 0u;
    for (;;) {
        sum = 0u; cnt = 0u; mine = 0u;
#pragma unroll
        for (unsigned j = 0; j < 16; ++j) { const unsigned c = xb_ld(&bar[XB_XCNT(j)]); sum += c; cnt += (c > 0u) ? 1u : 0u; mine = (j == x) ? c : mine; }
        if (sum == G) break;
        __builtin_amdgcn_s_sleep(1);
        if ((++sp & 255u) == 0u) { if (xb_ld(&bar[XB_TMO])) break; if (sp > XB_SPIN_CAP) { atomicAdd(&bar[XB_TMO], 1u); break; } }
    }
    nloc = mine > 0u ? mine : 1u; nx = cnt > 0u ? cnt : 1u;
}
__device__ __forceinline__ void xcd_barrier(const XcdBarrier& b) {
    asm volatile("s_waitcnt vmcnt(0)" ::: "memory");
    __syncthreads();
    if (threadIdx.x == 0) {
        unsigned* bar = b.bar;
        __builtin_amdgcn_s_waitcnt(0);
        unsigned nloc = b.st[0], nx = b.st[1];
        if (nloc == 0u) { xcd_barrier_complete(bar, b.x, nloc, nx); b.st[0] = nloc; b.st[1] = nx; }
        const unsigned old = xb_add(&bar[XB_XSUB(b.x)], 1u);
        const unsigned gen = old / nloc;
        if (old + 1u == (gen + 1u) * nloc) {
            __builtin_amdgcn_fence(__ATOMIC_RELEASE, "agent");
            asm volatile("s_waitcnt vmcnt(0)" ::: "memory");
            const unsigned og = xb_add(&bar[XB_TOP], 1u);
            const unsigned tg = og / nx;
            if (og + 1u == (tg + 1u) * nx) xb_add(&bar[XB_TOPGEN], 1u);
            else XB_SPIN(xb_ld(&bar[XB_TOPGEN]) == tg, bar);
            __builtin_amdgcn_fence(__ATOMIC_ACQUIRE, "agent");
            xb_add(&bar[XB_XGEN(b.x)], 1u);
            asm volatile("s_waitcnt vmcnt(0)" ::: "memory");
        } else {
            XB_SPIN(xb_ld(&bar[XB_XGEN(b.x)]) == gen, bar);
            __builtin_amdgcn_fence(__ATOMIC_ACQUIRE, "agent");
            asm volatile("s_waitcnt vmcnt(0)" ::: "memory");
        }
    }
    __syncthreads();
}

__global__ void __launch_bounds__(NTHREADS, 2) fwd_megakernel(Args a) {
    extern __shared__ __attribute__((aligned(16))) unsigned char smem[];
    LAS unsigned char* lds = (LAS unsigned char*)smem;
    cg::grid_group grid = cg::this_grid();
    bf16_t* WT = (bf16_t*)(a.ws + WS_WT);
    bf16_t* H = (bf16_t*)(a.ws + WS_H);
    const float* MOD = (const float*)(a.ws + WS_MOD);

    volatile LAS unsigned* xst = (volatile LAS unsigned*)(lds + XST_OFF);
    if (threadIdx.x == 0) { xst[0] = 0u; xst[1] = 0u; xst[2] = 0u; xst[3] = 0u; }
    __syncthreads();
    const XcdBarrier xb = xcd_barrier_post((unsigned*)(a.ws + WS_BAR), xst);
    prep_phase(a, lds);
    grid.sync();

#pragma unroll 1
    for (int layer = 0; layer < 4; ++layer) {
        const int kind = layer % 3, slot = layer / 3;
        const float* modl = MOD + (size_t)layer * 48 * 6144;
        norm_phase(a, layer == 0, a.in[13] + layer * 1024, layer, 0);
        xcd_barrier(xb);
        Epi res{}; res.mode = 0; res.X = a.out; res.srcP = layer == 0 ? a.in[0] : nullptr; res.srcS = layer == 0 ? a.in[1] : nullptr; res.gate = modl + 2 * 1024;
        if (kind == 0) {
            Epi e{}; e.mode = 1; e.o0 = (bf16_t*)(a.ws + BG_QKV); e.ld0 = 3072; e.t1 = 12; e.o1 = (bf16_t*)(a.ws + BG_Z); e.ld1 = 1024; e.t2 = 16; e.o2 = (float*)(a.ws + BG_AB);
            gemm_phase(lds, H, WT + WT_GIN + (size_t)slot * 4352 * 1024, MT, 4352, 1024, e);
            xcd_barrier(xb);
            gdn_pre_phase(a, lds, slot);
            xcd_barrier(xb);
            gdn_phase(a, lds, slot);
            xcd_barrier(xb);
            gemm_phase(lds, H, WT + WT_GO + (size_t)slot * 1024 * 1024, MT, 1024, 1024, res);
        } else if (kind == 1) {
            Epi e{}; e.mode = 1; e.o0 = (bf16_t*)(a.ws + BM_PROJ); e.ld0 = 768; e.t1 = 3; e.t2 = 3;
            gemm_phase(lds, H, WT + WT_MIN, MT, 768, 1024, e);
            xcd_barrier(xb);
            mla_prep_phase(a);
            xcd_barrier(xb);
            Epi eq{}; eq.mode = 1; eq.o0 = (bf16_t*)(a.ws + BM_Q); eq.ld0 = 1536; eq.t1 = 6; eq.t2 = 6;
            gemm_phase(lds, (const bf16_t*)(a.ws + BM_CQ), WT + WT_QUP, MT, 1536, 384, eq);
            Epi ek{}; ek.mode = 1; ek.o0 = (bf16_t*)(a.ws + BM_KV); ek.ld0 = 2048; ek.t1 = 8; ek.t2 = 8;
            gemm_phase(lds, (const bf16_t*)(a.ws + BM_CKV), WT + WT_KVUP, MK, 2048, 256, ek);
            xcd_barrier(xb);
            attn_phase<true>(a, lds);
            xcd_barrier(xb);
            gemm_phase(lds, H, WT + WT_MO, MT, 1024, 1024, res);
        } else {
            Epi e{}; e.mode = 1; e.o0 = (bf16_t*)(a.ws + BS_PROJ); e.ld0 = 1536; e.t1 = 6; e.t2 = 6;
            gemm_phase(lds, H, WT + WT_SIN, MT, 1536, 1024, e);
            xcd_barrier(xb);
            swa_state_out(a);
            attn_phase<false>(a, lds);
            xcd_barrier(xb);
            gemm_phase(lds, H, WT + WT_SO, MT, 1024, 1024, res);
        }
        xcd_barrier(xb);
        norm_phase(a, false, a.in[14] + layer * 1024, layer, 3);
        xcd_barrier(xb);
        {
            Epi e{}; e.mode = 2; e.o0 = (bf16_t*)(a.ws + BF_U); e.o2 = (float*)(a.ws + BF_GD); e.ud = (float*)(a.ws + BF_UD);
            e.cw = a.in[33] + (size_t)layer * 3 * DFF; e.cb = a.in[34] + (size_t)layer * DFF; e.cwl = (const LAS bf16_t*)(lds + CWL_OFF);
            gemm_phase(lds, H, WT + WT_FIN + (size_t)layer * 5632 * 1024, MT, 5632, 1024, e);
        }
        xcd_barrier(xb);
        ffn_fix_phase(a, layer);
        xcd_barrier(xb);
        {
            Epi r2{}; r2.mode = 0; r2.X = a.out; r2.srcP = nullptr; r2.srcS = nullptr; r2.gate = modl + 5 * 1024;
            gemm_phase(lds, (const bf16_t*)(a.ws + BF_U), WT + WT_FOUT + (size_t)layer * 1024 * 2816, MT, 1024, 2816, r2);
        }
        xcd_barrier(xb);
    }
    final_norm_phase(a);
}

extern "C" void kernel_launch(void* const* d_in, const int* in_sizes, int n_in, void* d_out, int out_size, void* d_ws, size_t ws_size, hipStream_t stream) {
    static int grid = 0;
    if (grid == 0) {
        if (n_in != 36 || (size_t)out_size != O_END || ws_size < WS_NEED) {
            fprintf(stderr, "kernel_launch: unexpected shapes: n_in %d out %d (want %zu) ws %zu (need %zu)\n", n_in, out_size, (size_t)O_END, ws_size, (size_t)WS_NEED);
            grid = -1; return; }
        int dev = 0, cus = 0, per_cu = 0;
        hipGetDevice(&dev);
        hipDeviceGetAttribute(&cus, hipDeviceAttributeMultiprocessorCount, dev);
        if (hipFuncSetAttribute((const void*)fwd_megakernel, hipFuncAttributeMaxDynamicSharedMemorySize, LDS_BYTES) != hipSuccess) { fprintf(stderr, "kernel_launch: hipFuncSetAttribute failed\n"); grid = -1; return; }
        if (hipOccupancyMaxActiveBlocksPerMultiprocessor(&per_cu, (const void*)fwd_megakernel, NTHREADS, LDS_BYTES) != hipSuccess || per_cu < 1) {
            fprintf(stderr, "kernel_launch: occupancy query gives %d blocks per CU\n", per_cu); (void)hipGetLastError(); per_cu = 1; }
        grid = cus;
    }
    if (grid < 0) return;
    Args a{};
    for (int i = 0; i < 36; ++i) a.in[i] = (const float*)d_in[i];
    a.out = (float*)d_out; a.ws = (unsigned char*)d_ws;
    if (hipMemsetAsync((char*)d_ws + WS_BAR, 0, XCD_BAR_WORDS * 4, stream) != hipSuccess) { fprintf(stderr, "kernel_launch: memset of the barrier words failed\n"); return; }
    void* args[] = {&a};
    hipError_t e = hipLaunchCooperativeKernel((const void*)fwd_megakernel, dim3(grid), dim3(NTHREADS), args, LDS_BYTES, stream);
    if (e != hipSuccess) fprintf(stderr, "kernel_launch: cooperative launch failed: %s (grid %d)\n", hipGetErrorString(e), grid);
}
```
